# Optimizing an MI355X kernel written in HIP

```python
import math
import jax, jax.numpy as jnp
from jax import lax
import numpy as np

D_MODEL = 1024
BATCH = 16
SEQ = 4096
DEPTH = 1

DA_HEADS = 8
DA_HEAD_DIM = 64
DA_V_DIM = 2 * DA_HEAD_DIM
ROPE_THETA = 10000.0
QUERY_BLOCK = 128
POOL_WINDOWS = (2, 4, 8, 16)
POOL_GROUPS = len(POOL_WINDOWS)
POOL_GROUP_DIM = 128
POOL_DIM = POOL_GROUPS * POOL_GROUP_DIM
MEM_LEN = 256
MEM_HEADS = 4
MEM_HEAD_DIM = 128
MEM_DIM = MEM_HEADS * MEM_HEAD_DIM
Q_DIM = DA_HEADS * 2 * DA_HEAD_DIM
K_DIM = DA_HEADS * 2 * DA_HEAD_DIM
V_DIM = DA_HEADS * DA_V_DIM
N_BRANCHES = 3
GATE_DIM = N_BRANCHES * D_MODEL
IN_DIM = Q_DIM + K_DIM + V_DIM + POOL_DIM + MEM_DIM + GATE_DIM
SPLITS = (Q_DIM, Q_DIM + K_DIM, Q_DIM + K_DIM + V_DIM,
          Q_DIM + K_DIM + V_DIM + POOL_DIM,
          Q_DIM + K_DIM + V_DIM + POOL_DIM + MEM_DIM)
N_EXPERTS = 32
TOP_K = 4
D_EXPERT = D_MODEL
SWIGLU_LIMIT = 7.0
SWIGLU_ALPHA = 1.702
EXPERT_BLOCK = 256
LAYER_INDEX = 1
LAMBDA_INIT = 0.8 - 0.6 * math.exp(-0.3 * (LAYER_INDEX - 1))
EPS = 1e-6
NEG_INF = -1e30

kernel_name = "hybrid_gated_diffattn_pool_memxattn_moe"


def rmsnorm(t, g):
    t32 = t.astype(jnp.float32)
    t32 = t32 * lax.rsqrt(jnp.mean(t32 * t32, axis=-1, keepdims=True) + EPS)
    return (t32 * g.astype(jnp.float32)).astype(t.dtype)


def rotary(t, cos, sin):
    half = t.shape[-1] // 2
    t32 = t.astype(jnp.float32)
    c = cos[None, :, None, None, :]
    s = sin[None, :, None, None, :]
    t1, t2 = t32[..., :half], t32[..., half:]
    return jnp.concatenate([t1 * c - t2 * s, t2 * c + t1 * s], axis=-1).astype(t.dtype)


def diff_attention(q, k, v, lam):
    B, S = q.shape[0], q.shape[1]
    nb = S // QUERY_BLOCK
    scale = 1.0 / math.sqrt(DA_HEAD_DIM)
    qb = q.reshape(B, nb, QUERY_BLOCK, DA_HEADS, 2, DA_HEAD_DIM).transpose(1, 0, 2, 3, 4, 5)
    key_pos = jnp.arange(S)

    def block(args):
        q_blk, i = args
        s = jnp.einsum('bqhcd,bkhcd->bhcqk', q_blk, k).astype(jnp.float32) * scale
        q_pos = i * QUERY_BLOCK + jnp.arange(QUERY_BLOCK)
        mask = key_pos[None, :] <= q_pos[:, None]
        s = jnp.where(mask, s, NEG_INF)
        p = jax.nn.softmax(s, axis=-1)
        a = p[:, :, 0] - lam * p[:, :, 1]
        return jnp.einsum('bhqk,bkhe->bqhe', a.astype(v.dtype), v)

    o = lax.map(block, (qb, jnp.arange(nb)))
    return o.transpose(1, 0, 2, 3, 4).reshape(B, S, DA_HEADS, DA_V_DIM)


def multiscale_pool(u, pool_w, pool_scale):
    B, S, _ = u.shape
    u32 = u.astype(jnp.float32)
    cs = jnp.concatenate([jnp.zeros((B, 1, POOL_DIM), jnp.float32),
                          jnp.cumsum(u32, axis=1)], axis=1)
    t1 = jnp.arange(S) + 1
    outs = []
    for g, w in enumerate(POOL_WINDOWS):
        sl = slice(g * POOL_GROUP_DIM, (g + 1) * POOL_GROUP_DIM)
        csg = cs[..., sl]
        prev = jnp.concatenate([jnp.zeros((B, w - 1, POOL_GROUP_DIM), jnp.float32),
                                csg[:, :S + 1 - w]], axis=1)
        count = jnp.minimum(t1, w).astype(jnp.float32)[None, :, None]
        outs.append((csg[:, 1:] - prev) / count - u32[..., sl])
    z = jnp.stack(outs, axis=2)
    z = jnp.einsum('bsgc,gcd->bsgd', z, pool_w.astype(jnp.float32)).reshape(B, S, POOL_DIM)
    return (z * pool_scale.astype(jnp.float32)).astype(u.dtype)


def memory_cross_attention(q_mem, mem, g_mem, w_mem_kv, mq_norm, mk_norm):
    B, S = q_mem.shape[0], q_mem.shape[1]
    M = mem.shape[1]
    qm = rmsnorm(q_mem.reshape(B, S, MEM_HEADS, MEM_HEAD_DIM), mq_norm)
    kv = rmsnorm(mem, g_mem) @ w_mem_kv
    km, vm = jnp.split(kv, 2, axis=-1)
    km = rmsnorm(km.reshape(B, M, MEM_HEADS, MEM_HEAD_DIM), mk_norm)
    vm = vm.reshape(B, M, MEM_HEADS, MEM_HEAD_DIM)
    s = jnp.einsum('bshd,bmhd->bhsm', qm, km).astype(jnp.float32) / math.sqrt(MEM_HEAD_DIM)
    p = jax.nn.softmax(s, axis=-1)
    o = jnp.einsum('bhsm,bmhd->bshd', p.astype(vm.dtype), vm)
    return o.reshape(B, S, MEM_DIM)


def moe(hn, w_router, b_router, w_gate, b_gate, w_up, b_up, w_down, b_down):
    B, S, D = hn.shape
    T = B * S
    xt = hn.reshape(T, D)
    logits = (xt @ w_router + b_router).astype(jnp.float32)
    top_val, top_idx = lax.top_k(logits, TOP_K)
    gates = jax.nn.softmax(top_val, axis=-1)
    A = T * TOP_K
    e_flat = top_idx.reshape(A).astype(jnp.int32)
    tok_flat = jnp.arange(A, dtype=jnp.int32) // TOP_K
    w_flat = gates.reshape(A)
    order = jnp.argsort(e_flat)
    e_sorted, tok_sorted, w_sorted = e_flat[order], tok_flat[order], w_flat[order]
    counts = jnp.zeros((N_EXPERTS,), jnp.int32).at[e_flat].add(1)
    padded = ((counts + EXPERT_BLOCK - 1) // EXPERT_BLOCK) * EXPERT_BLOCK
    off = jnp.cumsum(counts) - counts
    pend = jnp.cumsum(padded)
    poff = pend - padded
    dest = poff[e_sorted] + (jnp.arange(A, dtype=jnp.int32) - off[e_sorted])
    n_blocks = -(-A // EXPERT_BLOCK) + N_EXPERTS
    P = n_blocks * EXPERT_BLOCK
    tok_buf = jnp.zeros((P,), jnp.int32).at[dest].set(tok_sorted)
    w_buf = jnp.zeros((P,), jnp.float32).at[dest].set(w_sorted)
    block_e = jnp.minimum(
        jnp.searchsorted(pend, jnp.arange(n_blocks, dtype=jnp.int32) * EXPERT_BLOCK, side='right'),
        N_EXPERTS - 1)

    def body(i, y):
        rows = lax.dynamic_slice(tok_buf, (i * EXPERT_BLOCK,), (EXPERT_BLOCK,))
        wts = lax.dynamic_slice(w_buf, (i * EXPERT_BLOCK,), (EXPERT_BLOCK,))
        e = block_e[i]
        xb = xt[rows]
        g = jnp.minimum(xb @ w_gate[e] + b_gate[e], SWIGLU_LIMIT)
        u = jnp.clip(xb @ w_up[e] + b_up[e], -SWIGLU_LIMIT, SWIGLU_LIMIT)
        act = g * jax.nn.sigmoid(SWIGLU_ALPHA * g) * (u + 1.0)
        out = act @ w_down[e] + b_down[e]
        return y.at[rows].add(out * wts[:, None].astype(out.dtype))

    y = lax.fori_loop(0, n_blocks, body, jnp.zeros_like(xt))
    return y.reshape(B, S, D)


def setup_inputs(seed: int = 0) -> dict:
    key = jax.random.key(seed)
    ks = jax.random.split(key, 32)
    f32 = jnp.float32
    nrm = lambda k, shape, fan_in: jax.random.normal(k, shape, f32) * (fan_in ** -0.5)
    gain = lambda k, n: 1.0 + 0.05 * jax.random.normal(k, (n,), f32)
    return {
        "x": jax.random.normal(ks[0], (BATCH, SEQ, D_MODEL), f32),
        "mem": jax.random.normal(ks[1], (BATCH, MEM_LEN, D_MODEL), f32),
        "g_mix": gain(ks[2], D_MODEL),
        "w_in": nrm(ks[3], (D_MODEL, IN_DIM), D_MODEL),
        "b_gates": 0.02 * jax.random.normal(ks[4], (GATE_DIM,), f32),
        "q_norm": gain(ks[5], DA_HEAD_DIM),
        "k_norm": gain(ks[6], DA_HEAD_DIM),
        "lambda_q1": 0.1 * jax.random.normal(ks[7], (DA_HEAD_DIM,), f32),
        "lambda_k1": 0.1 * jax.random.normal(ks[8], (DA_HEAD_DIM,), f32),
        "lambda_q2": 0.1 * jax.random.normal(ks[9], (DA_HEAD_DIM,), f32),
        "lambda_k2": 0.1 * jax.random.normal(ks[10], (DA_HEAD_DIM,), f32),
        "g_subln": gain(ks[11], DA_V_DIM),
        "pool_w": nrm(ks[12], (POOL_GROUPS, POOL_GROUP_DIM, POOL_GROUP_DIM), POOL_GROUP_DIM),
        "pool_scale": 1.0 + 0.1 * jax.random.normal(ks[13], (POOL_DIM,), f32),
        "g_mem": gain(ks[14], D_MODEL),
        "w_mem_kv": nrm(ks[15], (D_MODEL, 2 * MEM_DIM), D_MODEL),
        "mq_norm": gain(ks[16], MEM_HEAD_DIM),
        "mk_norm": gain(ks[17], MEM_HEAD_DIM),
        "w_b_attn": nrm(ks[18], (V_DIM, D_MODEL), V_DIM),
        "w_b_pool": nrm(ks[19], (POOL_DIM, D_MODEL), POOL_DIM),
        "w_b_mem": nrm(ks[20], (MEM_DIM, D_MODEL), MEM_DIM),
        "w_out": nrm(ks[21], (D_MODEL, D_MODEL), D_MODEL),
        "g_ffn": gain(ks[22], D_MODEL),
        "w_router": nrm(ks[23], (D_MODEL, N_EXPERTS), D_MODEL),
        "b_router": 0.01 * jax.random.normal(ks[24], (N_EXPERTS,), f32),
        "w_gate": nrm(ks[25], (N_EXPERTS, D_MODEL, D_EXPERT), D_MODEL),
        "b_gate": 0.02 * jax.random.normal(ks[26], (N_EXPERTS, D_EXPERT), f32),
        "w_up": nrm(ks[27], (N_EXPERTS, D_MODEL, D_EXPERT), D_MODEL),
        "b_up": 0.02 * jax.random.normal(ks[28], (N_EXPERTS, D_EXPERT), f32),
        "w_down": nrm(ks[29], (N_EXPERTS, D_EXPERT, D_MODEL), D_EXPERT),
        "b_down": 0.02 * jax.random.normal(ks[30], (N_EXPERTS, D_MODEL), f32),
    }


def reference(x, mem, g_mix, w_in, b_gates, q_norm, k_norm, lambda_q1, lambda_k1,
              lambda_q2, lambda_k2, g_subln, pool_w, pool_scale, g_mem, w_mem_kv,
              mq_norm, mk_norm, w_b_attn, w_b_pool, w_b_mem, w_out, g_ffn,
              w_router, b_router, w_gate, b_gate, w_up, b_up, w_down, b_down):
    B, S, D = x.shape
    inv_freq = ROPE_THETA ** (-jnp.arange(0, DA_HEAD_DIM, 2, dtype=jnp.float32) / DA_HEAD_DIM)
    ang = jnp.arange(S, dtype=jnp.float32)[:, None] * inv_freq[None, :]
    cos, sin = jnp.cos(ang), jnp.sin(ang)
    lam = (jnp.exp(jnp.sum(lambda_q1.astype(jnp.float32) * lambda_k1.astype(jnp.float32)))
           - jnp.exp(jnp.sum(lambda_q2.astype(jnp.float32) * lambda_k2.astype(jnp.float32)))
           + LAMBDA_INIT)

    h = x
    for _ in range(DEPTH):
        xn = rmsnorm(h, g_mix)
        proj = xn @ w_in
        q, k, v, u_pool, q_mem, gate_logits = jnp.split(proj, SPLITS, axis=-1)

        q = rotary(rmsnorm(q.reshape(B, S, DA_HEADS, 2, DA_HEAD_DIM), q_norm), cos, sin)
        k = rotary(rmsnorm(k.reshape(B, S, DA_HEADS, 2, DA_HEAD_DIM), k_norm), cos, sin)
        v = v.reshape(B, S, DA_HEADS, DA_V_DIM)
        o = diff_attention(q, k, v, lam)
        o = rmsnorm(o, g_subln) * (1.0 - LAMBDA_INIT)
        y_attn = o.reshape(B, S, V_DIM) @ w_b_attn

        y_pool = multiscale_pool(u_pool, pool_w, pool_scale) @ w_b_pool

        y_mem = memory_cross_attention(q_mem, mem, g_mem, w_mem_kv, mq_norm, mk_norm) @ w_b_mem

        g = jax.nn.sigmoid((gate_logits + b_gates).astype(jnp.float32)).reshape(B, S, N_BRANCHES, D)
        merged = (g[:, :, 0] * y_attn.astype(jnp.float32)
                  + g[:, :, 1] * y_pool.astype(jnp.float32)
                  + g[:, :, 2] * y_mem.astype(jnp.float32)).astype(h.dtype)
        h = h + merged @ w_out

        h = h + moe(rmsnorm(h, g_ffn), w_router, b_router, w_gate, b_gate,
                    w_up, b_up, w_down, b_down)
    return h
```

```cpp
#include <hip/hip_runtime.h>
#include <cstdio>
#include <cstdint>

#define GAS __attribute__((address_space(1)))
#define LAS __attribute__((address_space(3)))
typedef unsigned short bf16_t;
typedef short bf16x8 __attribute__((ext_vector_type(8)));
typedef short s16x4 __attribute__((ext_vector_type(4)));
typedef float f32x2 __attribute__((ext_vector_type(2)));
typedef float f32x4 __attribute__((ext_vector_type(4)));
typedef float f32x16 __attribute__((ext_vector_type(16)));
typedef unsigned u32x2 __attribute__((ext_vector_type(2)));
typedef unsigned u32x4 __attribute__((ext_vector_type(4)));
typedef __bf16 bf16x2_t __attribute__((ext_vector_type(2)));

constexpr int BATCH = 16, SEQ = 4096, DM = 1024, T = BATCH * SEQ;
constexpr int IN_DIM = 7168, MEMLEN = 256, TM = BATCH * MEMLEN;
constexpr int NE = 32, TOPK = 4, HALF_T = T / 2, CAP = HALF_T;
constexpr float EPS = 1e-6f;
constexpr float LAMBDA_INIT = 0.2f;
constexpr float LOG2E = 1.4426950408889634f;
constexpr float C2 = 0.125f * LOG2E;
constexpr float C3 = 0.08838834764831845f * LOG2E;
constexpr int NWAVES = 8;

constexpr size_t MiB = 1u << 20;
constexpr size_t WS_CTL = 0, CTL_ZERO_BYTES = 1 * MiB;
constexpr size_t WS_WIN = 2 * MiB;
constexpr size_t WS_WKV = 16 * MiB;
constexpr size_t WS_WBA = 18 * MiB;
constexpr size_t WS_WEFF = 20 * MiB;
constexpr size_t WS_WBM = 21 * MiB;
constexpr size_t WS_WOUT = 22 * MiB;
constexpr size_t WS_ROPE = 24 * MiB;
constexpr size_t WS_WR = 25 * MiB;
constexpr size_t WS_MEMN = 26 * MiB;
constexpr size_t WS_KM = 34 * MiB;
constexpr size_t WS_VM = 38 * MiB;
constexpr size_t WS_TSLOT = 42 * MiB;
constexpr size_t WS_TW = 43 * MiB;
constexpr size_t WS_RSTD = 44 * MiB;
constexpr size_t WS_LIST = 46 * MiB;
constexpr size_t WS_A = 64 * MiB;
constexpr size_t WS_GATES = 192 * MiB;
constexpr size_t WS_V = 576 * MiB;
constexpr size_t WS_UP = 704 * MiB;
constexpr size_t WS_QM = 768 * MiB;
constexpr size_t WS_Z = 832 * MiB;
constexpr size_t WS_OM = 896 * MiB;
constexpr size_t WS_WGU = 192 * MiB;
constexpr size_t WS_WD = 320 * MiB;
constexpr size_t WS_ACT = 384 * MiB;
constexpr size_t WS_OSLOT = 656 * MiB;
constexpr int PMAX = HALF_T * TOPK + NE * 256;
constexpr size_t WS_END = 928 * MiB;
static_assert(WS_ACT + (size_t)PMAX * DM * 2 <= WS_OSLOT && WS_OSLOT + (size_t)PMAX * DM * 2 <= WS_END, "moe buffers");
static_assert(WS_LIST + (size_t)2 * NE * CAP * 4 <= WS_A, "list");
constexpr int CW_TMO = 0, CW_BAR = 4096, CW_CNT = 8192;

constexpr int RING_BYTES = 131072;
constexpr int WSF_OFF = RING_BYTES;
constexpr int MISC_OFF = WSF_OFF + 2048;
constexpr int LDS_BYTES = 147456;

#define RLX_AGENT __ATOMIC_RELAXED, __HIP_MEMORY_SCOPE_AGENT
#define LDS_WAIT() asm volatile("s_waitcnt lgkmcnt(0)" ::: "memory")
#define VM_WAIT() asm volatile("s_waitcnt vmcnt(0)" ::: "memory")
#define WG_BAR() asm volatile("s_waitcnt vmcnt(0) lgkmcnt(0)\n\ts_barrier" ::: "memory")

__device__ __forceinline__ unsigned cvtpk(float lo, float hi) { f32x2 v = {lo, hi}; bf16x2_t b = __builtin_convertvector(v, bf16x2_t); return __builtin_bit_cast(unsigned, b); }
__device__ __forceinline__ float bf_lo(unsigned w) { return __uint_as_float(w << 16); }
__device__ __forceinline__ float bf_hi(unsigned w) { return __uint_as_float(w & 0xffff0000u); }
__device__ __forceinline__ float wave_sum(float v) {
#pragma unroll
    for (int o = 1; o < 64; o <<= 1) v += __shfl_xor(v, o);
    return v;
}
__device__ __forceinline__ float fast_sigmoid(float x) { return __builtin_amdgcn_rcpf(1.0f + __builtin_amdgcn_exp2f(-LOG2E * x)); }
namespace pg8 {
constexpr int BM = 256, BK = 64, HALF = 128, HTB = HALF * BK * 2  , STAGE_BYTES = 8 * HTB, NXCD = 8, WGM = 8;

__host__ __device__ __forceinline__ int lds_byte(int r, int c) { const int st = (r >> 4) * 2 + (c >> 5), rr = r & 15, cc = c & 31, ob = rr * 64 + cc * 2; return st * 1024 + (ob ^ (((ob >> 9) & 1) << 5)); }
__host__ __device__ __forceinline__ void stage_rc(int b, int& R, int& C) { const int st = b / 1024, sb = b % 1024, swz = sb ^ (((sb >> 9) & 1) << 5); R = (st >> 1) * 16 + swz / 64; C = (st & 1) * 32 + (swz % 64) / 2; }
__host__ __device__ __forceinline__ int perm32(int rho) { const int n = rho >> 4, i = rho & 15; return 8 * (i >> 2) + 4 * n + (i & 3); }

struct Unit { int pm, pn, e, rb, nvalid; };

struct StaticOrder {
    int nM, nN, nwg, G, c;
    __device__ void init(int M, int N, int G_, int c_) { nM = M / BM; nN = N / BM; nwg = nM * nN; G = G_; c = c_; }
    __device__ bool next(int i, Unit& u) const {
        const long L = (long)i * G + c; if (L >= nwg) return false;
        int wgid = (int)L; { const int q = nwg / NXCD, r = nwg % NXCD, xcd = wgid % NXCD, off = wgid / NXCD; wgid = (xcd < r ? xcd * (q + 1) : r * (q + 1) + (xcd - r) * q) + off; }
        const int nig = WGM * nN, gid = wgid / nig, fm = gid * WGM, gsz = (nM - fm) < WGM ? (nM - fm) : WGM;
        u.pm = fm + ((wgid % nig) % gsz); u.pn = (wgid % nig) / gsz; u.e = 0; u.rb = 0; u.nvalid = 256; return true;
    }
};

struct ABPlain {
    static constexpr bool GATHER = false;
    const bf16_t* A; const bf16_t* Bt; int K;
    __device__ __forceinline__ const char* a_base(const Unit& u) const { return (const char*)A + (size_t)u.pm * BM * K * 2; }
    __device__ __forceinline__ const char* b_base(const Unit& u) const { return (const char*)Bt + (size_t)u.pn * BM * K * 2; }
    __device__ __forceinline__ unsigned a_off(const Unit&, int r, int c) const { return (unsigned)(r * K + c) * 2u; }
};

template <class Epi, class Sched, class AB, bool ALIGN_EPI, bool SP2>
__device__ __forceinline__ void gemm_phase(const int tid, LAS unsigned char* lds, const AB& g, const Sched& S, const Epi& E) {
    static_assert(SP2, "only the SP2 loop is kept");
    const int wid = __builtin_amdgcn_readfirstlane(tid >> 6), lane = tid & 63, wr = wid >> 2, wc = wid & 3, fr = lane & 15, fq = lane >> 4;
    const int K = g.K, nt = K / BK;
    unsigned voffB[2]; int rA[2], cA_[2];
#pragma unroll
    for (int i = 0; i < 2; ++i) { int R, C; stage_rc(tid * 16 + i * 8192, R, C); const int Rb = Epi::PERM ? ((R & ~31) + perm32(R & 31)) : R;
        rA[i] = R; cA_[i] = C; voffB[i] = (unsigned)(Rb * K + C) * 2u; }
    const size_t kstep = (size_t)(BK * 2);
    const size_t hstep = (size_t)HALF * K * 2;
    const unsigned ldsw = (unsigned)wid * 1024u;
    const int aoff = lds_byte(wr * 64 + fr, fq * 8), boff = lds_byte(wc * 32 + fr, fq * 8);
#define PG8_SA(b, h) (((b) * 2 + (h)) * HTB)
#define PG8_SB(b, h) ((4 + (b) * 2 + (h)) * HTB)
#define PG8_STAGE(bufoff, gbase, voff) do { _Pragma("unroll") for (int _i = 0; _i < 2; ++_i) \
        __builtin_amdgcn_global_load_lds((const unsigned*)((const char*)(gbase) + (voff)[_i]), (LAS unsigned*)(lds + (bufoff) + ldsw + _i * 8192), 16, 0, 0); } while (0)
#define PG8_LDA(dst, b, h) do { _Pragma("unroll") for (int m = 0; m < 4; ++m) _Pragma("unroll") for (int k = 0; k < 2; ++k) dst[m][k] = *(const LAS bf16x8*)(lds + PG8_SA(b, h) + aoff + m * 2048 + k * 1024); } while (0)
#define PG8_LDB(dst, b, h) do { _Pragma("unroll") for (int n = 0; n < 2; ++n) _Pragma("unroll") for (int k = 0; k < 2; ++k) dst[n][k] = *(const LAS bf16x8*)(lds + PG8_SB(b, h) + boff + n * 2048 + k * 1024); } while (0)
#define PG8_MMA(ai, bj, At, Bt) do { __builtin_amdgcn_s_setprio(1); _Pragma("unroll") for (int m = 0; m < 4; ++m) _Pragma("unroll") for (int n = 0; n < 2; ++n) _Pragma("unroll") for (int k = 0; k < 2; ++k) \
        acc[ai][bj][m][n] = __builtin_amdgcn_mfma_f32_16x16x32_bf16(Bt[n][k], At[m][k], acc[ai][bj][m][n], 0, 0, 0); __builtin_amdgcn_s_setprio(0); } while (0)
#define PG8_WAIT_V(n) asm volatile("s_waitcnt vmcnt(" #n ")" ::: "memory")
#define PG8_WAIT_L(n) asm volatile("s_waitcnt lgkmcnt(" #n ")" ::: "memory")
#define PG8_BAR __builtin_amdgcn_s_barrier()
#define PG8_SCHED __builtin_amdgcn_sched_barrier(0)
    Unit cur, nxt; int ui = 0;
    if (!S.next(0, cur)) return;
    f32x4 acc[2][2][4][2];
#pragma unroll
    for (int a = 0; a < 2; ++a)
#pragma unroll
        for (int b = 0; b < 2; ++b)
#pragma unroll
            for (int m = 0; m < 4; ++m)
#pragma unroll
                for (int n = 0; n < 2; ++n) acc[a][b][m][n] = (f32x4){0.f, 0.f, 0.f, 0.f};
    bf16x8 At[4][2], B0[2][2], B1[2][2];
    unsigned vA0[2], vA1[2], nA0[2], nA1[2], tk[4] = {0u, 0u, 0u, 0u};
#pragma unroll
    for (int i = 0; i < 2; ++i) { vA0[i] = g.a_off(cur, rA[i], cA_[i]); vA1[i] = g.a_off(cur, HALF + rA[i], cA_[i]); nA0[i] = vA0[i]; nA1[i] = vA1[i]; }
    const char* cA = g.a_base(cur); const char* cB = g.b_base(cur);
    PG8_STAGE(PG8_SB(0, 0), cB, voffB); PG8_STAGE(PG8_SB(0, 1), cB + hstep, voffB); PG8_STAGE(PG8_SA(0, 0), cA, vA0); PG8_STAGE(PG8_SA(0, 1), cA, vA1);
    if (wr == 1) PG8_BAR;
    PG8_WAIT_V(2); PG8_BAR;
    PG8_STAGE(PG8_SB(1, 0), cB + kstep, voffB); PG8_STAGE(PG8_SA(1, 0), cA + kstep, vA0); PG8_STAGE(PG8_SB(1, 1), cB + hstep + kstep, voffB);
    PG8_WAIT_V(6); PG8_BAR;
    for (;;) {
        const bool has_next = S.next(ui + 1, nxt);
        const char* nA = has_next ? g.a_base(nxt) : cA; const char* nB = has_next ? g.b_base(nxt) : cB;
        if constexpr (AB::GATHER) {
            if (has_next) {
#pragma unroll
                for (int i = 0; i < 2; ++i) {
                    asm volatile("global_load_dword %0, %1, off" : "=v"(tk[i]) : "v"(g.tok_ptr(nxt, rA[i])) : "memory");
                    asm volatile("global_load_dword %0, %1, off" : "=v"(tk[2 + i]) : "v"(g.tok_ptr(nxt, HALF + rA[i])) : "memory");
                }
            }
        }
        for (int t = 0; t < nt; t += 2) {
            const bool last = (t == nt - 2);
            const char* a1 = cA + (size_t)(t + 1) * kstep;
            const char* a2 = last ? nA : cA + (size_t)(t + 2) * kstep; const char* b2 = last ? nB : cB + (size_t)(t + 2) * kstep;
            const char* a3 = a2 + kstep; const char* b3 = b2 + kstep;
            unsigned w0[2], w1[2];
            if constexpr (AB::GATHER) {
                if (last && has_next) {
                    asm volatile("s_waitcnt vmcnt(8)" : "+v"(tk[0]), "+v"(tk[1]), "+v"(tk[2]), "+v"(tk[3]) :: "memory");
#pragma unroll
                    for (int i = 0; i < 2; ++i) { nA0[i] = g.off_from_tok(tk[i], cA_[i]); nA1[i] = g.off_from_tok(tk[2 + i], cA_[i]); }
                } else if (last) {
#pragma unroll
                    for (int i = 0; i < 2; ++i) { nA0[i] = vA0[i]; nA1[i] = vA1[i]; }
                }
            }
#pragma unroll
            for (int i = 0; i < 2; ++i) { w0[i] = (AB::GATHER && last) ? nA0[i] : vA0[i]; w1[i] = (AB::GATHER && last) ? nA1[i] : vA1[i]; }
            PG8_LDB(B0, 0, 0); PG8_LDB(B1, 0, 1); PG8_SCHED; PG8_LDA(At, 0, 0); PG8_STAGE(PG8_SA(1, 1), a1, vA1);
            PG8_WAIT_V(8); PG8_WAIT_L(0); PG8_BAR; PG8_MMA(0, 0, At, B0); PG8_MMA(0, 1, At, B1); PG8_BAR; PG8_SCHED;
            PG8_LDA(At, 0, 1); PG8_STAGE(PG8_SB(0, 0), b2, voffB); PG8_STAGE(PG8_SB(0, 1), b2 + hstep, voffB); PG8_STAGE(PG8_SA(0, 0), a2, w0);
            PG8_WAIT_V(8); PG8_WAIT_L(0); PG8_BAR; PG8_MMA(1, 0, At, B0); PG8_MMA(1, 1, At, B1); PG8_BAR; PG8_SCHED;
            PG8_LDB(B0, 1, 0); PG8_LDB(B1, 1, 1); PG8_SCHED; PG8_LDA(At, 1, 0); PG8_STAGE(PG8_SA(0, 1), a2, w1);
            PG8_WAIT_V(8); PG8_WAIT_L(0); PG8_BAR; PG8_MMA(0, 0, At, B0); PG8_MMA(0, 1, At, B1); PG8_BAR; PG8_SCHED;
            PG8_LDA(At, 1, 1); PG8_STAGE(PG8_SB(1, 0), b3, voffB); PG8_STAGE(PG8_SB(1, 1), b3 + hstep, voffB); PG8_STAGE(PG8_SA(1, 0), a3, w0);
            PG8_WAIT_V(8); PG8_WAIT_L(0); PG8_BAR; PG8_MMA(1, 0, At, B0); PG8_MMA(1, 1, At, B1); PG8_BAR; PG8_SCHED;
        }
        if constexpr (ALIGN_EPI) { if (wr == 0) PG8_BAR; }
        if constexpr (!Epi::AFTER_DRAIN) { E(acc, cur, wr, wc, fr, fq); }
        if (!has_next) break;
#pragma unroll
        for (int a = 0; a < 2; ++a)
#pragma unroll
            for (int b = 0; b < 2; ++b)
#pragma unroll
                for (int m = 0; m < 4; ++m)
#pragma unroll
                    for (int n = 0; n < 2; ++n) acc[a][b][m][n] = (f32x4){0.f, 0.f, 0.f, 0.f};
        cur = nxt; cA = nA; cB = nB; ++ui;
        if constexpr (AB::GATHER) {
#pragma unroll
            for (int i = 0; i < 2; ++i) { vA0[i] = nA0[i]; vA1[i] = nA1[i]; }
        }
        if constexpr (ALIGN_EPI) { if (wr == 1) PG8_BAR; }
    }
    PG8_WAIT_V(0);
    if constexpr (!ALIGN_EPI) { if (wr == 0) PG8_BAR; }
    PG8_BAR;
    if constexpr (Epi::AFTER_DRAIN) { E.fused(acc, cur, wr, wc, fr, fq, lds, wid, lane); }
#undef PG8_SA
#undef PG8_SB
#undef PG8_STAGE
#undef PG8_LDA
#undef PG8_LDB
#undef PG8_MMA
#undef PG8_WAIT_V
#undef PG8_WAIT_L
#undef PG8_BAR
#undef PG8_SCHED
}
}
namespace epi {
using pg8::Unit; using pg8::HALF; using pg8::BM;
typedef f32x4 Acc[2][2][4][2];

__device__ __forceinline__ u32x4 pack8(const f32x4& a, const f32x4& b) { u32x4 w; w.x = cvtpk(a[0], a[1]); w.y = cvtpk(a[2], a[3]); w.z = cvtpk(b[0], b[1]); w.w = cvtpk(b[2], b[3]); return w; }

__device__ __forceinline__ void store_plain(const Acc& acc, bf16_t* O, int ld, int col0, int row0) {
#pragma unroll
    for (int ai = 0; ai < 2; ++ai)
#pragma unroll
        for (int m = 0; m < 4; ++m) { bf16_t* rp = O + (size_t)(row0 + ai * HALF + m * 16) * ld + col0;
#pragma unroll
            for (int bj = 0; bj < 2; ++bj) *(u32x4*)(rp + bj * HALF) = pack8(acc[ai][bj][m][0], acc[ai][bj][m][1]); }
}
struct EpiInProj {
    static constexpr bool PERM = true, AFTER_DRAIN = false;
    bf16_t *Q, *Kk, *V, *UP, *QM, *G; const float *qn, *kn, *cs, *sn, *bg;
    __device__ __forceinline__ void operator()(const Acc& acc, const Unit& u, int wr, int wc, int fr, int fq) const {
        const int pn = u.pn; const int row0 = u.pm * BM + wr * 64 + fr;
        if (pn < 8) {
            const bool isq = pn < 4; bf16_t* O = isq ? Q : Kk; const float* gn = isq ? qn : kn; const float sc = isq ? C2 : 1.0f;
            const int ct = (isq ? pn : pn - 4) * 256 + wc * 64 + 8 * fq;
            f32x4 g[2][2];
#pragma unroll
            for (int bj = 0; bj < 2; ++bj)
#pragma unroll
                for (int n = 0; n < 2; ++n) g[bj][n] = *(const f32x4*)(gn + 32 * bj + 8 * fq + 4 * n);
#pragma unroll
            for (int ai = 0; ai < 2; ++ai)
#pragma unroll
                for (int m = 0; m < 4; ++m) {
                    const int row = row0 + ai * HALF + m * 16; const int pos = row & (SEQ - 1);
                    float ss = 0.f;
#pragma unroll
                    for (int bj = 0; bj < 2; ++bj)
#pragma unroll
                        for (int n = 0; n < 2; ++n) { const f32x4 x = acc[ai][bj][m][n]; ss += (x[0] * x[0] + x[1] * x[1]) + (x[2] * x[2] + x[3] * x[3]); }
                    ss += __shfl_xor(ss, 16); ss += __shfl_xor(ss, 32);
                    const float rstd = __builtin_amdgcn_rsqf(ss * (1.0f / 64.0f) + EPS) * sc;
                    f32x4 o1[2], o2[2];
#pragma unroll
                    for (int n = 0; n < 2; ++n) {
                        const f32x4 c = *(const f32x4*)(cs + pos * 32 + 8 * fq + 4 * n), s = *(const f32x4*)(sn + pos * 32 + 8 * fq + 4 * n);
                        const f32x4 t1 = acc[ai][0][m][n] * rstd * g[0][n], t2 = acc[ai][1][m][n] * rstd * g[1][n];
                        o1[n] = t1 * c - t2 * s; o2[n] = t2 * c + t1 * s;
                    }
                    bf16_t* rp = O + (size_t)row * DM + ct;
                    *(u32x4*)(rp) = pack8(o1[0], o1[1]); *(u32x4*)(rp + 32) = pack8(o2[0], o2[1]);
                }
        } else if (pn < 12) { store_plain(acc, V, DM, (pn - 8) * 256 + wc * 32 + 8 * fq, row0);
        } else if (pn < 14) { store_plain(acc, UP, 512, (pn - 12) * 256 + wc * 32 + 8 * fq, row0);
        } else if (pn < 16) { store_plain(acc, QM, 512, (pn - 14) * 256 + wc * 32 + 8 * fq, row0);
        } else {
            const int col0 = (pn - 16) * 256 + wc * 32 + 8 * fq;
            f32x4 bv[2][2];
#pragma unroll
            for (int bj = 0; bj < 2; ++bj)
#pragma unroll
                for (int n = 0; n < 2; ++n) bv[bj][n] = *(const f32x4*)(bg + col0 + bj * HALF + 4 * n);
#pragma unroll
            for (int ai = 0; ai < 2; ++ai)
#pragma unroll
                for (int m = 0; m < 4; ++m) { bf16_t* rp = G + (size_t)(row0 + ai * HALF + m * 16) * 3072 + col0;
#pragma unroll
                    for (int bj = 0; bj < 2; ++bj) { f32x4 a = acc[ai][bj][m][0] + bv[bj][0], b = acc[ai][bj][m][1] + bv[bj][1];
#pragma unroll
                        for (int e = 0; e < 4; ++e) { a[e] = fast_sigmoid(a[e]); b[e] = fast_sigmoid(b[e]); }
                        *(u32x4*)(rp + bj * HALF) = pack8(a, b); } }
        }
    }
};

struct EpiMemKV {
    static constexpr bool PERM = true, AFTER_DRAIN = true;
    bf16_t *KM, *VM; const float *mk, *mq;
    __device__ __forceinline__ void fused(const Acc& acc, const Unit& u, int wr, int wc, int fr, int fq, LAS unsigned char* lds, int wid, int lane) const {
        const int pn = u.pn;
        if (pn < 2) {
            LAS float* P = (LAS float*)lds;
#pragma unroll
            for (int ai = 0; ai < 2; ++ai)
#pragma unroll
                for (int m = 0; m < 4; ++m)
#pragma unroll
                    for (int bj = 0; bj < 2; ++bj) {
                        float ss = 0.f;
#pragma unroll
                        for (int n = 0; n < 2; ++n) { const f32x4 x = acc[ai][bj][m][n]; ss += (x[0] * x[0] + x[1] * x[1]) + (x[2] * x[2] + x[3] * x[3]); }
                        ss += __shfl_xor(ss, 16); ss += __shfl_xor(ss, 32);
                        if (fq == 0) P[((ai * HALF + wr * 64 + m * 16 + fr) * 2 + bj) * 4 + wc] = ss;
                    }
            WG_BAR();
            const int d0 = wc * 32 + 8 * fq;
            f32x4 gn[2];
#pragma unroll
            for (int n = 0; n < 2; ++n) { const f32x4 a = *(const f32x4*)(mk + d0 + 4 * n), b = *(const f32x4*)(mq + d0 + 4 * n); gn[n] = a * b * C3; }
#pragma unroll
            for (int ai = 0; ai < 2; ++ai)
#pragma unroll
                for (int m = 0; m < 4; ++m) { const int rl = ai * HALF + wr * 64 + m * 16 + fr;
#pragma unroll
                    for (int bj = 0; bj < 2; ++bj) {
                        const f32x4 p4 = *(const LAS f32x4*)(P + (rl * 2 + bj) * 4);
                        const float rstd = __builtin_amdgcn_rsqf(((p4[0] + p4[1]) + (p4[2] + p4[3])) * (1.0f / 128.0f) + EPS);
                        const f32x4 a = acc[ai][bj][m][0] * rstd * gn[0], b = acc[ai][bj][m][1] * rstd * gn[1];
                        *(u32x4*)(KM + (size_t)(u.pm * BM + rl) * 512 + (2 * pn + bj) * 128 + d0) = pack8(a, b);
                    } }
        } else {
            const int col0 = (pn - 2) * 256 + wc * 32 + 8 * fq;
#pragma unroll
            for (int ai = 0; ai < 2; ++ai)
#pragma unroll
                for (int m = 0; m < 4; ++m) { bf16_t* rp = VM + (size_t)(u.pm * BM + ai * HALF + wr * 64 + m * 16 + fr) * 512 + col0;
#pragma unroll
                    for (int bj = 0; bj < 2; ++bj) *(u32x4*)(rp + bj * HALF) = pack8(acc[ai][bj][m][0], acc[ai][bj][m][1]); }
        }
    }
};

template <int MODE  > struct EpiMerge {
    static constexpr bool PERM = true, AFTER_DRAIN = false;
    const bf16_t* G; int goff; bf16_t* M;
    __device__ __forceinline__ void operator()(const Acc& acc, const Unit& u, int wr, int wc, int fr, int fq) const {
        const int row0 = u.pm * BM + wr * 64 + fr, col0 = u.pn * BM + wc * 32 + 8 * fq;
#pragma unroll
        for (int ai = 0; ai < 2; ++ai)
#pragma unroll
            for (int m = 0; m < 4; ++m) { const size_t row = (size_t)(row0 + ai * HALF + m * 16);
#pragma unroll
                for (int bj = 0; bj < 2; ++bj) {
                    const u32x4 gw = *(const u32x4*)(G + row * 3072 + goff + col0 + bj * HALF);
                    bf16_t* mp = M + row * DM + col0 + bj * HALF;
                    f32x4 a = acc[ai][bj][m][0], b = acc[ai][bj][m][1];
                    a[0] *= bf_lo(gw.x); a[1] *= bf_hi(gw.x); a[2] *= bf_lo(gw.y); a[3] *= bf_hi(gw.y);
                    b[0] *= bf_lo(gw.z); b[1] *= bf_hi(gw.z); b[2] *= bf_lo(gw.w); b[3] *= bf_hi(gw.w);
                    if (MODE == 1) { const u32x4 pw = *(const u32x4*)mp;
                        a[0] += bf_lo(pw.x); a[1] += bf_hi(pw.x); a[2] += bf_lo(pw.y); a[3] += bf_hi(pw.y);
                        b[0] += bf_lo(pw.z); b[1] += bf_hi(pw.z); b[2] += bf_lo(pw.w); b[3] += bf_hi(pw.w); }
                    *(u32x4*)mp = pack8(a, b);
                } }
    }
};

struct EpiOut {
    static constexpr bool PERM = true, AFTER_DRAIN = false;
    const float* X; float* H; bf16_t* HB;
    __device__ __forceinline__ void operator()(const Acc& acc, const Unit& u, int wr, int wc, int fr, int fq) const {
        const int row0 = u.pm * BM + wr * 64 + fr, col0 = u.pn * BM + wc * 32 + 8 * fq;
#pragma unroll
        for (int ai = 0; ai < 2; ++ai)
#pragma unroll
            for (int m = 0; m < 4; ++m) { const size_t off = (size_t)(row0 + ai * HALF + m * 16) * DM + col0;
#pragma unroll
                for (int bj = 0; bj < 2; ++bj) {
                    const f32x4 a = acc[ai][bj][m][0] + *(const f32x4*)(X + off + bj * HALF), b = acc[ai][bj][m][1] + *(const f32x4*)(X + off + bj * HALF + 4);
                    *(f32x4*)(H + off + bj * HALF) = a; *(f32x4*)(H + off + bj * HALF + 4) = b;
                    *(u32x4*)(HB + off + bj * HALF) = pack8(a, b);
                } }
    }
};

struct EpiGateUp {
    static constexpr bool PERM = true, AFTER_DRAIN = false;
    const unsigned* list; const float* rstd; const float *bgate, *bup; bf16_t* ACT;
    __device__ __forceinline__ void operator()(const Acc& acc, const Unit& u, int wr, int wc, int fr, int fq) const {
        const int cole = u.pn * 128 + wc * 32 + 8 * fq;
        f32x4 bgv[2], buv[2];
#pragma unroll
        for (int n = 0; n < 2; ++n) { bgv[n] = *(const f32x4*)(bgate + u.e * DM + cole + 4 * n); buv[n] = *(const f32x4*)(bup + u.e * DM + cole + 4 * n); }
        const unsigned* le = list + (size_t)u.e * CAP + u.rb * 256;
#pragma unroll
        for (int ai = 0; ai < 2; ++ai)
#pragma unroll
            for (int m = 0; m < 4; ++m) {
                const int rl = ai * HALF + wr * 64 + m * 16 + fr; const int sl = rl < u.nvalid ? rl : u.nvalid - 1;
                const float rs = rstd[le[sl]];
                f32x4 o[2];
#pragma unroll
                for (int n = 0; n < 2; ++n)
#pragma unroll
                    for (int e = 0; e < 4; ++e) {
                        float g = acc[ai][0][m][n][e] * rs + bgv[n][e], up = acc[ai][1][m][n][e] * rs + buv[n][e];
                        g = fminf(g, 7.0f); up = fminf(fmaxf(up, -7.0f), 7.0f);
                        o[n][e] = g * fast_sigmoid(1.702f * g) * (up + 1.0f);
                    }
                *(u32x4*)(ACT + (size_t)(u.pm * BM + rl) * DM + cole) = pack8(o[0], o[1]);
            }
    }
};

struct EpiDown {
    static constexpr bool PERM = true, AFTER_DRAIN = false;
    const float* bdown; bf16_t* OS;
    __device__ __forceinline__ void operator()(const Acc& acc, const Unit& u, int wr, int wc, int fr, int fq) const {
        const int col0 = u.pn * BM + wc * 32 + 8 * fq;
        f32x4 bv[2][2];
#pragma unroll
        for (int bj = 0; bj < 2; ++bj)
#pragma unroll
            for (int n = 0; n < 2; ++n) bv[bj][n] = *(const f32x4*)(bdown + u.e * DM + col0 + bj * HALF + 4 * n);
#pragma unroll
        for (int ai = 0; ai < 2; ++ai)
#pragma unroll
            for (int m = 0; m < 4; ++m) { bf16_t* rp = OS + (size_t)(u.pm * BM + ai * HALF + wr * 64 + m * 16 + fr) * DM + col0;
#pragma unroll
                for (int bj = 0; bj < 2; ++bj) *(u32x4*)(rp + bj * HALF) = pack8(acc[ai][bj][m][0] + bv[bj][0], acc[ai][bj][m][1] + bv[bj][1]); }
    }
};
}

namespace pg8 {
struct ABMoeGU {
    static constexpr bool GATHER = true;
    const bf16_t* A; const bf16_t* Bt; const unsigned* list; int K;
    __device__ __forceinline__ const char* a_base(const Unit&) const { return (const char*)A; }
    __device__ __forceinline__ const char* b_base(const Unit& u) const { return (const char*)Bt + ((size_t)u.e * 2048 + (size_t)u.pn * BM) * K * 2; }
    __device__ __forceinline__ const unsigned* tok_ptr(const Unit& u, int r) const { const int sl = r < u.nvalid ? r : u.nvalid - 1; return list + (size_t)u.e * CAP + u.rb * 256 + sl; }
    __device__ __forceinline__ unsigned off_from_tok(unsigned tok, int c) const { return (tok * (unsigned)K + (unsigned)c) * 2u; }
    __device__ __forceinline__ unsigned a_off(const Unit& u, int r, int c) const { return off_from_tok(*tok_ptr(u, r), c); }
};
struct ABMoeDown {
    static constexpr bool GATHER = false;
    const bf16_t* A; const bf16_t* Bt; int K;
    __device__ __forceinline__ const char* a_base(const Unit& u) const { return (const char*)A + (size_t)u.pm * BM * K * 2; }
    __device__ __forceinline__ const char* b_base(const Unit& u) const { return (const char*)Bt + ((size_t)u.e * DM + (size_t)u.pn * BM) * K * 2; }
    __device__ __forceinline__ unsigned a_off(const Unit&, int r, int c) const { return (unsigned)(r * K + c) * 2u; }
};
struct MoeOrder {
    const volatile LAS int* cnt; const volatile LAS int* cum; int nN, G, c, total;
    __device__ __forceinline__ bool next(int i, Unit& u) const {
        const long L = (long)i * G + c; if (L >= total) return false;
        const int rbg = (int)(L / nN); u.pn = (int)(L % nN);
        int e = 0;
#pragma unroll 1
        for (int j = 1; j < NE; ++j) e += (rbg >= cum[j]) ? 1 : 0;
        u.e = e; u.rb = rbg - cum[e]; u.pm = rbg; const int left = cnt[e] - u.rb * 256; u.nvalid = left < 256 ? left : 256; return true;
    }
};
}
namespace att {
#define MFMA32(a, b, c) __builtin_amdgcn_mfma_f32_32x32x16_bf16((a), (b), (c), 0, 0, 0)
__device__ __forceinline__ int crow(int r, int hi) { return (r & 3) + 8 * (r >> 2) + 4 * hi; }
typedef short v4i16_t __attribute__((ext_vector_type(4)));
__device__ __forceinline__ s16x4 vtr(const LAS char* p) { return __builtin_bit_cast(s16x4, __builtin_amdgcn_ds_read_tr16_b64_v4i16((LAS v4i16_t*)p)); }

template <int ND0> __device__ __forceinline__ void qk_tile(f32x16& p0, f32x16& p1, const LAS char* kb, const bf16x8* qr) {
    f32x16 z = {0.f, 0.f, 0.f, 0.f, 0.f, 0.f, 0.f, 0.f, 0.f, 0.f, 0.f, 0.f, 0.f, 0.f, 0.f, 0.f};
    p0 = z; p1 = z;
#pragma unroll
    for (int d0 = 0; d0 < ND0; ++d0) {
        const bf16x8 b0 = *(const LAS bf16x8*)(kb + d0 * 2048), b1 = *(const LAS bf16x8*)(kb + d0 * 2048 + 512);
        p0 = MFMA32(b0, qr[d0], p0); p1 = MFMA32(b1, qr[d0], p1);
    }
}
__device__ __forceinline__ void softmax_pv(f32x16& p0, f32x16& p1, float& mrow, float& lrow, f32x16 (&o)[4], const LAS char* vp, LAS float* wsf, int r32, int hi) {
    float a = fmaxf(p0[0], p1[0]);
#pragma unroll
    for (int r = 1; r < 16; ++r) a = fmaxf(a, fmaxf(p0[r], p1[r]));
    { auto rr = __builtin_amdgcn_permlane32_swap(__float_as_uint(a), __float_as_uint(a), false, false); a = fmaxf(__uint_as_float(rr[0]), __uint_as_float(rr[1])); }
    const float mnew = fmaxf(mrow, a);
    if (__any(mnew > mrow)) {
        const float f = __builtin_amdgcn_exp2f(mrow - mnew);
        lrow *= f;
        if (hi == 0) wsf[r32] = f;
        LDS_WAIT();
#pragma unroll
        for (int g = 0; g < 4; ++g) { const f32x4 f4 = *(const LAS f32x4*)(wsf + 8 * g + 4 * hi);
#pragma unroll
            for (int d = 0; d < 4; ++d) { o[d][4 * g + 0] *= f4[0]; o[d][4 * g + 1] *= f4[1]; o[d][4 * g + 2] *= f4[2]; o[d][4 * g + 3] *= f4[3]; } }
        mrow = mnew;
    }
    float s = 0.f;
#pragma unroll
    for (int r = 0; r < 16; ++r) { p0[r] = __builtin_amdgcn_exp2f(p0[r] - mrow); p1[r] = __builtin_amdgcn_exp2f(p1[r] - mrow); s += p0[r] + p1[r]; }
    lrow += s;
    bf16x8 pa[4];
    { u32x4 w;
      w.x = cvtpk(p0[0], p0[1]); w.y = cvtpk(p0[2], p0[3]); w.z = cvtpk(p0[4], p0[5]); w.w = cvtpk(p0[6], p0[7]); pa[0] = __builtin_bit_cast(bf16x8, w);
      w.x = cvtpk(p0[8], p0[9]); w.y = cvtpk(p0[10], p0[11]); w.z = cvtpk(p0[12], p0[13]); w.w = cvtpk(p0[14], p0[15]); pa[1] = __builtin_bit_cast(bf16x8, w);
      w.x = cvtpk(p1[0], p1[1]); w.y = cvtpk(p1[2], p1[3]); w.z = cvtpk(p1[4], p1[5]); w.w = cvtpk(p1[6], p1[7]); pa[2] = __builtin_bit_cast(bf16x8, w);
      w.x = cvtpk(p1[8], p1[9]); w.y = cvtpk(p1[10], p1[11]); w.z = cvtpk(p1[12], p1[13]); w.w = cvtpk(p1[14], p1[15]); pa[3] = __builtin_bit_cast(bf16x8, w); }
#pragma unroll
    for (int d = 0; d < 4; ++d)
#pragma unroll
        for (int ks = 0; ks < 4; ++ks) {
            const s16x4 lo = vtr(vp + d * 4096 + ks * 1024), hh = vtr(vp + d * 4096 + ks * 1024 + 512);
            const bf16x8 vf = (bf16x8){lo[0], lo[1], lo[2], lo[3], hh[0], hh[1], hh[2], hh[3]};
            o[d] = MFMA32(pa[ks], vf, o[d]);
        }
}

constexpr int DA_KOFF = 0, DA_VOFF = 32768, DA_BUF = 16384, DA_XLD = 132;
__device__ __forceinline__ void da_unit(const int tid, int b, int h, int qb, const bf16_t* Q, const bf16_t* Kg, const bf16_t* Vg, bf16_t* O, float lam, const float* gsub, LAS unsigned char* lds) {
    const int lane = tid & 63, r32 = lane & 31, hi = lane >> 5; const int wid = __builtin_amdgcn_readfirstlane(tid >> 6);
    const int comp = wid >> 2, w4 = wid & 3;
    const size_t rowbase = (size_t)b * SEQ;
    LAS float* wsf = (LAS float*)(lds + WSF_OFF) + wid * 64;
    bf16x8 qr[4];
    { const bf16_t* Qw = Q + (rowbase + qb * 128 + w4 * 32 + r32) * DM + h * 128 + comp * 64 + hi * 8;
#pragma unroll
      for (int d0 = 0; d0 < 4; ++d0) qr[d0] = *(const bf16x8*)(Qw + d0 * 16); }
    const int NT = 2 * qb + 2;
    const bf16_t* ksrc[2]; const bf16_t* vsrc[2]; unsigned kdst[2], vdst[2];
#pragma unroll
    for (int j = 0; j < 2; ++j) { const int p = wid * 2 + j;
        ksrc[j] = Kg + (rowbase + lane) * DM + h * 128 + (p >> 3) * 64 + (p & 7) * 8; kdst[j] = DA_KOFF + p * 1024;
        vsrc[j] = Vg + (rowbase + 16 * (p & 3) + (lane >> 2)) * DM + h * 128 + (p >> 2) * 32 + (lane & 3) * 8; vdst[j] = DA_VOFF + p * 1024; }
#define DA_DMA(t, buf) do { _Pragma("unroll") for (int j_ = 0; j_ < 2; ++j_) { \
        __builtin_amdgcn_global_load_lds((const unsigned*)(ksrc[j_] + (size_t)(t) * 64 * DM), (LAS unsigned*)(lds + kdst[j_] + (buf) * DA_BUF), 16, 0, 0); \
        __builtin_amdgcn_global_load_lds((const unsigned*)(vsrc[j_] + (size_t)(t) * 64 * DM), (LAS unsigned*)(lds + vdst[j_] + (buf) * DA_BUF), 16, 0, 0); } } while (0)
    float mrow = -__builtin_inff(), lrow = 0.f; f32x16 o[4];
#pragma unroll
    for (int d = 0; d < 4; ++d)
#pragma unroll
        for (int r = 0; r < 16; ++r) o[d][r] = 0.f;
    const LAS char* ldc = (const LAS char*)lds;
    const int vlane = ((lane >> 4) & 1) * 32 + (lane & 3) * 8 + (4 * hi + ((lane & 15) >> 2)) * 64;
    const int qpos = qb * 128 + w4 * 32 + r32;
    DA_DMA(0, 0);
    WG_BAR();
    for (int t = 0; t < NT; ++t) {
        const int buf = t & 1;
        if (t + 1 < NT) DA_DMA(t + 1, buf ^ 1);
        if (!(t == NT - 1 && w4 < 2)) {
            f32x16 p0, p1;
            qk_tile<4>(p0, p1, ldc + DA_KOFF + buf * DA_BUF + comp * 8192 + hi * 1024 + r32 * 16, qr);
            if (t >= NT - 2) {
                const int kb = 64 * t + 4 * hi;
#pragma unroll
                for (int r = 0; r < 16; ++r) { const int kv = kb + (r & 3) + 8 * (r >> 2); if (kv > qpos) p0[r] = -__builtin_inff(); if (kv + 32 > qpos) p1[r] = -__builtin_inff(); }
            }
            softmax_pv(p0, p1, mrow, lrow, o, ldc + DA_VOFF + buf * DA_BUF + vlane, wsf, r32, hi);
        }
        WG_BAR();
    }
#undef DA_DMA
    { auto rr = __builtin_amdgcn_permlane32_swap(__float_as_uint(lrow), __float_as_uint(lrow), false, false); lrow = __uint_as_float(rr[0]) + __uint_as_float(rr[1]); }
    if (hi == 0) wsf[32 + r32] = lrow;
    LDS_WAIT();
    float inv[16];
#pragma unroll
    for (int g = 0; g < 4; ++g) { const f32x4 l4 = *(const LAS f32x4*)(wsf + 32 + 8 * g + 4 * hi);
#pragma unroll
        for (int e = 0; e < 4; ++e) inv[4 * g + e] = __builtin_amdgcn_rcpf(l4[e]); }
    LAS float* X = (LAS float*)lds;
    if (comp == 1) {
#pragma unroll
        for (int d = 0; d < 4; ++d)
#pragma unroll
            for (int r = 0; r < 16; ++r) X[(w4 * 32 + crow(r, hi)) * DA_XLD + d * 32 + r32] = lam * o[d][r] * inv[r];
    }
    WG_BAR();
    if (comp == 0) {
#pragma unroll
        for (int d = 0; d < 4; ++d)
#pragma unroll
            for (int r = 0; r < 16; ++r) { LAS float* xp = X + (w4 * 32 + crow(r, hi)) * DA_XLD + d * 32 + r32; *xp = o[d][r] * inv[r] - *xp; }
    }
    WG_BAR();
    { const f32x2 g2 = *(const f32x2*)(gsub + 2 * lane);
#pragma unroll 4
      for (int i = 0; i < 16; ++i) { const int row = wid * 16 + i;
          const f32x2 v = *(const LAS f32x2*)(X + row * DA_XLD + 2 * lane);
          const float ss = wave_sum(v.x * v.x + v.y * v.y);
          const float rs = __builtin_amdgcn_rsqf(ss * (1.0f / 128.0f) + EPS) * (1.0f - LAMBDA_INIT);
          *(unsigned*)(O + (rowbase + qb * 128 + row) * DM + h * 128 + 2 * lane) = cvtpk(v.x * rs * g2.x, v.y * rs * g2.y); } }
    WG_BAR();
}

constexpr int CA_KOFF = 0, CA_VOFF = 65536;
__device__ __forceinline__ void ca_unit(const int tid, int b, int hm, int qc, const bf16_t* QM, const bf16_t* KM, const bf16_t* VM, bf16_t* OM, LAS unsigned char* lds) {
    const int lane = tid & 63, r32 = lane & 31, hi = lane >> 5; const int wid = __builtin_amdgcn_readfirstlane(tid >> 6);
    LAS float* wsf = (LAS float*)(lds + WSF_OFF) + wid * 64;
#pragma unroll
    for (int j = 0; j < 16; ++j) { const int P = wid * 16 + j;
        if (P < 64) { const int kt = P >> 4, ch = P & 15;
            __builtin_amdgcn_global_load_lds((const unsigned*)(KM + (size_t)(b * MEMLEN + 64 * kt + lane) * 512 + hm * 128 + ch * 8), (LAS unsigned*)(lds + CA_KOFF + kt * 16384 + ch * 1024), 16, 0, 0);
        } else { const int P2 = P - 64, kt = P2 >> 4, pv = P2 & 15;
            __builtin_amdgcn_global_load_lds((const unsigned*)(VM + (size_t)(b * MEMLEN + 64 * kt + 16 * (pv & 3) + (lane >> 2)) * 512 + hm * 128 + (pv >> 2) * 32 + (lane & 3) * 8), (LAS unsigned*)(lds + CA_VOFF + kt * 16384 + pv * 1024), 16, 0, 0); } }
    WG_BAR();
    const LAS char* ldc = (const LAS char*)lds;
    const int vlane = ((lane >> 4) & 1) * 32 + (lane & 3) * 8 + (4 * hi + ((lane & 15) >> 2)) * 64;
#pragma unroll 1
    for (int pass = 0; pass < 4; ++pass) {
        const size_t row0 = (size_t)b * SEQ + qc * 1024 + pass * 256 + wid * 32;
        bf16x8 qr[8]; float ssq = 0.f;
        { const bf16_t* Qw = QM + (row0 + r32) * 512 + hm * 128 + hi * 8;
#pragma unroll
          for (int d0 = 0; d0 < 8; ++d0) { qr[d0] = *(const bf16x8*)(Qw + d0 * 16); const u32x4 w = __builtin_bit_cast(u32x4, qr[d0]);
              float a;
              a = bf_lo(w.x); ssq += a * a; a = bf_hi(w.x); ssq += a * a; a = bf_lo(w.y); ssq += a * a; a = bf_hi(w.y); ssq += a * a;
              a = bf_lo(w.z); ssq += a * a; a = bf_hi(w.z); ssq += a * a; a = bf_lo(w.w); ssq += a * a; a = bf_hi(w.w); ssq += a * a; } }
        { auto rr = __builtin_amdgcn_permlane32_swap(__float_as_uint(ssq), __float_as_uint(ssq), false, false); ssq = __uint_as_float(rr[0]) + __uint_as_float(rr[1]); }
        const float rq = __builtin_amdgcn_rsqf(ssq * (1.0f / 128.0f) + EPS);
        float mrow = -__builtin_inff(), lrow = 0.f; f32x16 o[4];
#pragma unroll
        for (int d = 0; d < 4; ++d)
#pragma unroll
            for (int r = 0; r < 16; ++r) o[d][r] = 0.f;
#pragma unroll 1
        for (int kt = 0; kt < 4; ++kt) {
            f32x16 p0, p1;
            qk_tile<8>(p0, p1, ldc + CA_KOFF + kt * 16384 + hi * 1024 + r32 * 16, qr);
#pragma unroll
            for (int r = 0; r < 16; ++r) { p0[r] *= rq; p1[r] *= rq; }
            softmax_pv(p0, p1, mrow, lrow, o, ldc + CA_VOFF + kt * 16384 + vlane, wsf, r32, hi);
        }
        { auto rr = __builtin_amdgcn_permlane32_swap(__float_as_uint(lrow), __float_as_uint(lrow), false, false); lrow = __uint_as_float(rr[0]) + __uint_as_float(rr[1]); }
        if (hi == 0) wsf[32 + r32] = lrow;
        LDS_WAIT();
#pragma unroll
        for (int g = 0; g < 4; ++g) { const f32x4 l4 = *(const LAS f32x4*)(wsf + 32 + 8 * g + 4 * hi);
#pragma unroll
            for (int e = 0; e < 4; ++e) { const float iv = __builtin_amdgcn_rcpf(l4[e]); const int r = 4 * g + e;
                bf16_t* op = OM + (row0 + crow(r, hi)) * 512 + hm * 128 + r32;
#pragma unroll
                for (int d = 0; d < 4; ++d) op[d * 32] = (bf16_t)(cvtpk(o[d][r] * iv, 0.f) & 0xffffu); } }
        LDS_WAIT();
    }
    WG_BAR();
}
#undef MFMA32
}
#define XB_TMO      128
#define XB_XCNT(j)  (256  + 64 * (j))
#define XB_XSUB(j)  (1280 + 64 * (j))
#define XB_XGEN(j)  (2304 + 64 * (j))
#define XB_TOP      3328
#define XB_TOPGEN   3392
#define XCD_BAR_WORDS 3456
#define XB_SPIN_CAP (1u << 18)

__device__ __forceinline__ unsigned xb_ld(unsigned* p)              { return __hip_atomic_load(p, __ATOMIC_RELAXED, __HIP_MEMORY_SCOPE_AGENT); }
__device__ __forceinline__ unsigned xb_add(unsigned* p, unsigned v) { return __hip_atomic_fetch_add(p, v, __ATOMIC_RELAXED, __HIP_MEMORY_SCOPE_AGENT); }
__device__ __forceinline__ unsigned xb_xcc_id() { return (unsigned)__builtin_amdgcn_s_getreg((3 << 11) | 20) & 0xFu; }
#define XB_SPIN(cond, bar) do { unsigned _sp = 0; while (cond) { __builtin_amdgcn_s_sleep(1); \
    if ((++_sp & 255u) == 0u) { if (xb_ld(&(bar)[XB_TMO])) break; if (_sp > XB_SPIN_CAP) { atomicAdd(&(bar)[XB_TMO], 1u); break; } } } } while (0)

struct XcdBarrier { unsigned* bar; unsigned x; volatile LAS unsigned* st; };

__device__ __forceinline__ XcdBarrier xcd_barrier_post(unsigned* bar, volatile LAS unsigned* st) {
    XcdBarrier b; b.bar = bar; b.x = xb_xcc_id(); b.st = st;
    if (threadIdx.x == 0) (void)xb_add(&bar[XB_XCNT(b.x)], 1u);
    return b;
}
__device__ __forceinline__ void xcd_barrier_complete(unsigned* bar, unsigned x, unsigned& nloc, unsigned& nx) {
    const unsigned G = gridDim.x * gridDim.y * gridDim.z;
    unsigned sum, cnt, mine, sp = 0u;
    for (;;) {
        sum = 0u; cnt = 0u; mine = 0u;
#pragma unroll
        for (unsigned j = 0; j < 16; ++j) { const unsigned c = xb_ld(&bar[XB_XCNT(j)]); sum += c; cnt += (c > 0u) ? 1u : 0u; mine = (j == x) ? c : mine; }
        if (sum == G) break;
        __builtin_amdgcn_s_sleep(1);
        if ((++sp & 255u) == 0u) { if (xb_ld(&bar[XB_TMO])) break; if (sp > XB_SPIN_CAP) { atomicAdd(&bar[XB_TMO], 1u); break; } }
    }
    nloc = mine > 0u ? mine : 1u; nx = cnt > 0u ? cnt : 1u;
}
__device__ __forceinline__ void xcd_barrier(const XcdBarrier& b) {
    asm volatile("s_waitcnt vmcnt(0)" ::: "memory");
    __syncthreads();
    if (threadIdx.x == 0) {
        unsigned* bar = b.bar;
        __builtin_amdgcn_s_waitcnt(0);
        unsigned nloc = b.st[0], nx = b.st[1];
        if (nloc == 0u) { xcd_barrier_complete(bar, b.x, nloc, nx); b.st[0] = nloc; b.st[1] = nx; }
        const unsigned old = xb_add(&bar[XB_XSUB(b.x)], 1u);
        const unsigned gen = old / nloc;
        if (old + 1u == (gen + 1u) * nloc) {
            __builtin_amdgcn_fence(__ATOMIC_RELEASE, "agent");
            asm volatile("s_waitcnt vmcnt(0)" ::: "memory");
            const unsigned og = xb_add(&bar[XB_TOP], 1u);
            const unsigned tg = og / nx;
            if (og + 1u == (tg + 1u) * nx) xb_add(&bar[XB_TOPGEN], 1u);
            else XB_SPIN(xb_ld(&bar[XB_TOPGEN]) == tg, bar);
            __builtin_amdgcn_fence(__ATOMIC_ACQUIRE, "agent");
            xb_add(&bar[XB_XGEN(b.x)], 1u);
            asm volatile("s_waitcnt vmcnt(0)" ::: "memory");
        } else {
            XB_SPIN(xb_ld(&bar[XB_XGEN(b.x)]) == gen, bar);
            __builtin_amdgcn_fence(__ATOMIC_ACQUIRE, "agent");
            asm volatile("s_waitcnt vmcnt(0)" ::: "memory");
        }
    }
    __syncthreads();
}

typedef __attribute__((address_space(4))) const unsigned char* kptr_t;
__device__ __forceinline__ kptr_t karg_base() { kptr_t kp = (kptr_t)__builtin_amdgcn_kernarg_segment_ptr(); asm volatile("" : "+s"(kp)); return kp; }
typedef const float* cfptr_t; typedef float* fptr_t; typedef unsigned char* ucptr_t;
struct InTab { __device__ __forceinline__ const float* operator[](int i) const { return *(const __attribute__((address_space(4))) cfptr_t*)(karg_base() + 8 * i); } };
struct Frame {
    LAS unsigned char* lds; volatile LAS unsigned* MISC; unsigned* ctl;
    int tid, lane, wave, vcu, G;
    InTab in; float* out; unsigned char* ws;
};
#define MKFRAME(F) Frame F; { int t_ = threadIdx.x; asm volatile("" : "+v"(t_)); F.tid = t_; F.lane = t_ & 63; F.wave = __builtin_amdgcn_readfirstlane(t_ >> 6); \
    F.lds = (LAS unsigned char*)lds_raw; F.MISC = (volatile LAS unsigned*)(F.lds + MISC_OFF); F.G = gridDim.x; { const int bx_ = blockIdx.x; F.vcu = (F.G % 8 == 0) ? (bx_ % 8) * (F.G / 8) + bx_ / 8 : bx_; } \
    F.out = *(const __attribute__((address_space(4))) fptr_t*)(karg_base() + 31 * 8); F.ws = *(const __attribute__((address_space(4))) ucptr_t*)(karg_base() + 32 * 8); F.ctl = (unsigned*)(F.ws + WS_CTL); }
enum { I_X = 0, I_MEM, I_GMIX, I_WIN, I_BG, I_QN, I_KN, I_LQ1, I_LK1, I_LQ2, I_LK2, I_GSUB, I_PW, I_PS, I_GMEM, I_WKV, I_MQ, I_MK, I_WBA, I_WBP, I_WBM, I_WOUT, I_GFFN, I_WR, I_BR,
       I_WG, I_BGATE, I_WU, I_BUP, I_WD, I_BDOWN };
constexpr int MI_CNT = 16, MI_CUM = 48, MI_LC = 96, MI_LB = 128;

template <int MAP> __device__ __forceinline__ int rowmap(int n) {
    if (MAP == 1) { if (n >= 2048) return n; const int nl = n & 255; return (n & ~255) + 128 * ((nl >> 5) & 1) + 32 * (nl >> 6) + (nl & 31); }
    if (MAP == 2) return 256 * (n >> 7) + (n & 127);
    if (MAP == 3) return 256 * (n >> 7) + 128 + (n & 127);
    return n;
}
template <int MAP> __device__ __forceinline__ void transpose_item(const float* W, int K, int N, bf16_t* WT, const float* kscale, LAS float* scr, int item, int lane) {
    const int nblk = N / 32, kb = item / nblk, nb = item % nblk, k0 = 64 * kb, n0 = 32 * nb;
#pragma unroll
    for (int i = 0; i < 8; ++i) { const int kk = 8 * i + (lane >> 3), nn = (lane & 7) * 4;
        f32x4 v = *(const f32x4*)(W + (size_t)(k0 + kk) * N + n0 + nn);
        if (kscale) v = v * kscale[k0 + kk];
        LAS float* s = scr + kk * 33 + nn; s[0] = v[0]; s[1] = v[1]; s[2] = v[2]; s[3] = v[3]; }
    LDS_WAIT(); asm volatile("" ::: "memory");
    const int c = lane & 7;
#pragma unroll
    for (int j = 0; j < 4; ++j) { const int n = (lane >> 3) + 8 * j; const LAS float* s = scr + (8 * c) * 33 + n;
        u32x4 o; o.x = cvtpk(s[0 * 33], s[1 * 33]); o.y = cvtpk(s[2 * 33], s[3 * 33]); o.z = cvtpk(s[4 * 33], s[5 * 33]); o.w = cvtpk(s[6 * 33], s[7 * 33]);
        *(u32x4*)(WT + (size_t)rowmap<MAP>(n0 + n) * K + k0 + 8 * c) = o; }
    LDS_WAIT(); asm volatile("" ::: "memory");
}
__device__ __forceinline__ void rms_row_to_bf16(const float* xrow, const float* gain, bf16_t* orow, int lane) {
    const f32x4* xr = (const f32x4*)xrow + lane; const f32x4* gr = (const f32x4*)gain + lane;
    f32x4 v[4]; float s = 0.f;
#pragma unroll
    for (int j = 0; j < 4; ++j) { v[j] = xr[64 * j]; s += (v[j].x * v[j].x + v[j].y * v[j].y) + (v[j].z * v[j].z + v[j].w * v[j].w); }
    const float rstd = __builtin_amdgcn_rsqf(wave_sum(s) * (1.f / DM) + EPS);
    u32x2* o8 = (u32x2*)orow + lane;
#pragma unroll
    for (int j = 0; j < 4; ++j) { const f32x4 g = gr[64 * j]; u32x2 w; w.x = cvtpk(v[j].x * rstd * g.x, v[j].y * rstd * g.y); w.y = cvtpk(v[j].z * rstd * g.z, v[j].w * rstd * g.w); o8[64 * j] = w; }
}

__device__ __forceinline__ void p0_prologue(Frame& F) {
    LAS float* scr = (LAS float*)(F.lds + F.wave * 16384);
    const int gw = F.vcu * NWAVES + F.wave, NGW = F.G * NWAVES;
    unsigned char* ws = F.ws;
    constexpr int I_IN = (DM / 64) * (IN_DIM / 32), I_SQ = (DM / 64) * (DM / 32), I_BM = (512 / 64) * (DM / 32);
    constexpr int NITEMS = I_IN + 3 * I_SQ + I_BM;
    for (int it = gw; it < NITEMS; it += NGW) {
        int r = it;
        if (r < I_IN) { transpose_item<1>(F.in[I_WIN], DM, IN_DIM, (bf16_t*)(ws + WS_WIN), nullptr, scr, r, F.lane); continue; } r -= I_IN;
        if (r < I_SQ) { transpose_item<0>(F.in[I_WKV], DM, DM, (bf16_t*)(ws + WS_WKV), nullptr, scr, r, F.lane); continue; } r -= I_SQ;
        if (r < I_SQ) { transpose_item<0>(F.in[I_WBA], DM, DM, (bf16_t*)(ws + WS_WBA), nullptr, scr, r, F.lane); continue; } r -= I_SQ;
        if (r < I_SQ) { transpose_item<0>(F.in[I_WOUT], DM, DM, (bf16_t*)(ws + WS_WOUT), nullptr, scr, r, F.lane); continue; } r -= I_SQ;
        transpose_item<0>(F.in[I_WBM], 512, DM, (bf16_t*)(ws + WS_WBM), nullptr, scr, r, F.lane);
    }
    { const float* pw = F.in[I_PW]; const float* ps = F.in[I_PS]; const float* wbp = F.in[I_WBP]; bf16_t* WE = (bf16_t*)(ws + WS_WEFF);
      const int gt = F.vcu * 512 + F.tid, NGT = F.G * 512;
      for (int it = gt; it < 512 * DM; it += NGT) { const int d = it & (DM - 1), gc = it >> 10, g = gc >> 7;
          float a = 0.f;
#pragma unroll 8
          for (int j = 0; j < 128; ++j) a += pw[gc * 128 + j] * ps[g * 128 + j] * wbp[(size_t)(g * 128 + j) * DM + d];
          WE[(size_t)d * 512 + gc] = (bf16_t)(cvtpk(a, 0.f) & 0xffffu); }
      float* cs = (float*)(ws + WS_ROPE); float* sn = cs + SEQ * 32;
      for (int it = gt; it < SEQ * 32; it += NGT) { const int pos = it >> 5, j = it & 31;
          const float invf = exp2f(-(float)(2 * j) * (1.0f / 64.0f) * 13.287712379549449f);
          const float ang = (float)pos * invf;
          const double rev = (double)ang * 0.15915494309189535; const float fr = (float)(rev - floor(rev));
          cs[it] = __builtin_amdgcn_cosf(fr); sn[it] = __builtin_amdgcn_sinf(fr); }
      float* wr = (float*)(ws + WS_WR); const float* wrs = F.in[I_WR]; const float* gf = F.in[I_GFFN];
      for (int it = gt; it < DM * NE; it += NGT) { const int k = it >> 5, e = it & 31;
          wr[k * 32 + (((e >> 2) ^ ((k >> 1) & 7)) << 2) + (e & 3)] = gf[k] * wrs[it]; }
    }
    for (int m = gw; m < T; m += NGW) rms_row_to_bf16(F.in[I_X] + (size_t)m * DM, F.in[I_GMIX], (bf16_t*)(ws + WS_A) + (size_t)m * DM, F.lane);
    for (int m = gw; m < TM; m += NGW) rms_row_to_bf16(F.in[I_MEM] + (size_t)m * DM, F.in[I_GMEM], (bf16_t*)(ws + WS_MEMN) + (size_t)m * DM, F.lane);
}

__device__ __forceinline__ void p2_pool(Frame& F) {
    const bf16_t* U = (const bf16_t*)(F.ws + WS_UP); bf16_t* Z = (bf16_t*)(F.ws + WS_Z);
    const int gt = F.vcu * 512 + F.tid, NGT = F.G * 512;
    for (int it = gt; it < T * 64; it += NGT) { const int t = it >> 6, ch = it & 63, g = ch >> 4, w = 2 << g, pos = t & (SEQ - 1);
        const int cntw = (pos + 1 < w) ? pos + 1 : w;
        float a[8] = {0.f, 0.f, 0.f, 0.f, 0.f, 0.f, 0.f, 0.f}; float u0[8];
        const u32x4 c0 = *(const u32x4*)(U + (size_t)t * 512 + ch * 8);
        u0[0] = bf_lo(c0.x); u0[1] = bf_hi(c0.x); u0[2] = bf_lo(c0.y); u0[3] = bf_hi(c0.y); u0[4] = bf_lo(c0.z); u0[5] = bf_hi(c0.z); u0[6] = bf_lo(c0.w); u0[7] = bf_hi(c0.w);
#pragma unroll
        for (int e = 0; e < 8; ++e) a[e] = u0[e];
        for (int j = 1; j < cntw; ++j) { const u32x4 cj = *(const u32x4*)(U + (size_t)(t - j) * 512 + ch * 8);
            a[0] += bf_lo(cj.x); a[1] += bf_hi(cj.x); a[2] += bf_lo(cj.y); a[3] += bf_hi(cj.y); a[4] += bf_lo(cj.z); a[5] += bf_hi(cj.z); a[6] += bf_lo(cj.w); a[7] += bf_hi(cj.w); }
        const float ic = 1.0f / (float)cntw;
        u32x4 o; o.x = cvtpk(a[0] * ic - u0[0], a[1] * ic - u0[1]); o.y = cvtpk(a[2] * ic - u0[2], a[3] * ic - u0[3]); o.z = cvtpk(a[4] * ic - u0[4], a[5] * ic - u0[5]); o.w = cvtpk(a[6] * ic - u0[6], a[7] * ic - u0[7]);
        *(u32x4*)(Z + (size_t)t * 512 + ch * 8) = o; }
}

__device__ __forceinline__ void p5_router(Frame& F) {
    const float* H = F.out; const float* br = F.in[I_BR];
    unsigned* tslot = (unsigned*)(F.ws + WS_TSLOT); float* tw = (float*)(F.ws + WS_TW); float* rstd_o = (float*)(F.ws + WS_RSTD); unsigned* list = (unsigned*)(F.ws + WS_LIST);
    { const u32x4* src = (const u32x4*)(F.ws + WS_WR); LAS u32x4* dst = (LAS u32x4*)F.lds;
      for (int i = F.tid; i < DM * NE * 4 / 16; i += 512) dst[i] = src[i]; }
    volatile LAS unsigned* LC = F.MISC + MI_LC; volatile LAS unsigned* LB = F.MISC + MI_LB;
    WG_BAR();
    const LAS char* Wl = (const LAS char*)F.lds;
    for (int chunk = F.vcu; chunk < T / 256; chunk += F.G) {
        const int base = chunk * 256, hf = base >= HALF_T ? 1 : 0;
        if (F.tid < NE) LC[F.tid] = 0u;
        WG_BAR();
        unsigned myE = 0u, myR = 0u; float myW0 = 0.f, myW1 = 0.f, myW2 = 0.f, myW3 = 0.f;
#pragma unroll 1
        for (int rr = 0; rr < 32; ++rr) {
            const int row = base + F.wave * 32 + rr;
            float hv[16]; float ss = 0.f;
#pragma unroll
            for (int i = 0; i < 16; ++i) { hv[i] = H[(size_t)row * DM + F.lane + 64 * i]; }
            float v[32];
#pragma unroll
            for (int e = 0; e < 32; ++e) v[e] = 0.f;
#pragma unroll
            for (int i = 0; i < 16; ++i) { const int k = F.lane + 64 * i; const LAS char* wk = Wl + k * 128; const int sw = (k >> 1) & 7;
                ss += hv[i] * hv[i];
#pragma unroll
                for (int c8 = 0; c8 < 8; ++c8) { const f32x4 w4 = *(const LAS f32x4*)(wk + ((c8 ^ sw) << 4));
                    v[4 * c8 + 0] += hv[i] * w4[0]; v[4 * c8 + 1] += hv[i] * w4[1]; v[4 * c8 + 2] += hv[i] * w4[2]; v[4 * c8 + 3] += hv[i] * w4[3]; }
                __builtin_amdgcn_sched_barrier(0); }
            const float rstd = __builtin_amdgcn_rsqf(wave_sum(ss) * (1.0f / DM) + EPS);
#pragma unroll
            for (int j = 0; j < 16; ++j) { const bool up = (F.lane & 32) != 0; const float keep = up ? v[j + 16] : v[j], send = up ? v[j] : v[j + 16]; v[j] = keep + __shfl_xor(send, 32); }
#pragma unroll
            for (int j = 0; j < 8; ++j) { const bool up = (F.lane & 16) != 0; const float keep = up ? v[j + 8] : v[j], send = up ? v[j] : v[j + 8]; v[j] = keep + __shfl_xor(send, 16); }
#pragma unroll
            for (int j = 0; j < 4; ++j) { const bool up = (F.lane & 8) != 0; const float keep = up ? v[j + 4] : v[j], send = up ? v[j] : v[j + 4]; v[j] = keep + __shfl_xor(send, 8); }
#pragma unroll
            for (int j = 0; j < 2; ++j) { const bool up = (F.lane & 4) != 0; const float keep = up ? v[j + 2] : v[j], send = up ? v[j] : v[j + 2]; v[j] = keep + __shfl_xor(send, 4); }
            { const bool up = (F.lane & 2) != 0; const float keep = up ? v[1] : v[0], send = up ? v[0] : v[1]; v[0] = keep + __shfl_xor(send, 2); }
            v[0] += __shfl_xor(v[0], 1);
            const int myexp = F.lane >> 1;
            float val = v[0] * rstd + br[myexp];
            float tv[4]; int te[4];
#pragma unroll
            for (int k = 0; k < 4; ++k) {
                float m = val;
#pragma unroll
                for (int o = 1; o < 64; o <<= 1) m = fmaxf(m, __shfl_xor(m, o));
                const unsigned long long bal = __ballot(val == m);
                const int le = (int)__builtin_ctzll(bal) >> 1;
                tv[k] = m; te[k] = le;
                if (myexp == le) val = -__builtin_inff();
            }
            const float e1 = __expf(tv[1] - tv[0]), e2 = __expf(tv[2] - tv[0]), e3 = __expf(tv[3] - tv[0]); const float is = 1.0f / (1.0f + e1 + e2 + e3);
            unsigned rk[4];
            if (F.lane == 0) {
#pragma unroll
                for (int k = 0; k < 4; ++k) rk[k] = __hip_atomic_fetch_add((LAS unsigned*)&LC[te[k]], 1u, __ATOMIC_RELAXED, __HIP_MEMORY_SCOPE_WORKGROUP);
                rstd_o[row] = rstd;
            }
#pragma unroll
            for (int k = 0; k < 4; ++k) rk[k] = (unsigned)__builtin_amdgcn_readfirstlane((int)rk[k]);
            if (F.lane == rr) { myE = (unsigned)te[0] | ((unsigned)te[1] << 8) | ((unsigned)te[2] << 16) | ((unsigned)te[3] << 24);
                                myR = rk[0] | (rk[1] << 8) | (rk[2] << 16) | (rk[3] << 24);
                                myW0 = is; myW1 = e1 * is; myW2 = e2 * is; myW3 = e3 * is; }
        }
        WG_BAR();
        if (F.tid < NE) LB[F.tid] = xb_add(F.ctl + CW_CNT + hf * NE + F.tid, LC[F.tid]);
        WG_BAR();
        if (F.lane < 32) {
            const int row = base + F.wave * 32 + F.lane;
            u32x4 ts; f32x4 wv = {myW0, myW1, myW2, myW3};
#pragma unroll
            for (int k = 0; k < 4; ++k) { const unsigned e = (myE >> (8 * k)) & 0xffu, rnk = (myR >> (8 * k)) & 0xffu; const unsigned pos = LB[e] + rnk;
                ts[k] = (e << 24) | pos; list[((size_t)hf * NE + e) * CAP + pos] = (unsigned)row; }
            *(u32x4*)(tslot + (size_t)row * 4) = ts; *(f32x4*)(tw + (size_t)row * 4) = wv;
        }
        WG_BAR();
    }
}
__device__ __forceinline__ void p5_expert_weights(Frame& F) {
    LAS float* scr = (LAS float*)(F.lds + F.wave * 16384);
    const int gw = F.vcu * NWAVES + F.wave, NGW = F.G * NWAVES;
    constexpr int I_SQ = (DM / 64) * (DM / 32);
    for (int it = gw; it < 3 * NE * I_SQ; it += NGW) {
        const int mat = it / I_SQ, r = it % I_SQ, kind = mat / NE, e = mat % NE;
        if (kind == 0) transpose_item<2>(F.in[I_WG] + (size_t)e * DM * DM, DM, DM, (bf16_t*)(F.ws + WS_WGU) + (size_t)e * 2048 * DM, F.in[I_GFFN], scr, r, F.lane);
        else if (kind == 1) transpose_item<3>(F.in[I_WU] + (size_t)e * DM * DM, DM, DM, (bf16_t*)(F.ws + WS_WGU) + (size_t)e * 2048 * DM, F.in[I_GFFN], scr, r, F.lane);
        else transpose_item<0>(F.in[I_WD] + (size_t)e * DM * DM, DM, DM, (bf16_t*)(F.ws + WS_WD) + (size_t)e * DM * DM, nullptr, scr, r, F.lane);
    }
}
__device__ __forceinline__ void moe_tables(Frame& F, int hf) {
    WG_BAR();
    if (F.tid == 0) { int c = 0;
        for (int e = 0; e < NE; ++e) { const int n = (int)xb_ld(F.ctl + CW_CNT + hf * NE + e); F.MISC[MI_CNT + e] = (unsigned)n; F.MISC[MI_CUM + e] = (unsigned)c; c += (n + 255) >> 8; }
        F.MISC[MI_CUM + NE] = (unsigned)c; }
    WG_BAR();
}
__device__ __forceinline__ void moe_combine(Frame& F, int hf) {
    const unsigned* tslot = (const unsigned*)(F.ws + WS_TSLOT); const float* tw = (const float*)(F.ws + WS_TW); const bf16_t* OS = (const bf16_t*)(F.ws + WS_OSLOT);
    const int gw = F.vcu * NWAVES + F.wave, NGW = F.G * NWAVES;
    for (int t = hf * HALF_T + gw; t < (hf + 1) * HALF_T; t += NGW) {
        const u32x4 ts = *(const u32x4*)(tslot + (size_t)t * 4); const f32x4 wv = *(const f32x4*)(tw + (size_t)t * 4);
        f32x4 a[4]; float* op = F.out + (size_t)t * DM + 4 * F.lane;
#pragma unroll
        for (int j = 0; j < 4; ++j) a[j] = *(const f32x4*)(op + 256 * j);
#pragma unroll
        for (int k = 0; k < 4; ++k) { const unsigned e = ts[k] >> 24, pos = ts[k] & 0xffffffu; const size_t prow = (size_t)F.MISC[MI_CUM + e] * 256 + pos; const float w = wv[k];
            const bf16_t* rp = OS + prow * DM + 4 * F.lane;
#pragma unroll
            for (int j = 0; j < 4; ++j) { const u32x2 v = *(const u32x2*)(rp + 256 * j); a[j][0] += w * bf_lo(v.x); a[j][1] += w * bf_hi(v.x); a[j][2] += w * bf_lo(v.y); a[j][3] += w * bf_hi(v.y); } }
#pragma unroll
        for (int j = 0; j < 4; ++j) *(f32x4*)(op + 256 * j) = a[j];
    }
}
#ifndef MK_SPLIT
#define MK_SPLIT 1
#endif
constexpr int N_PHASES = 12;
struct Args { const float* in[31]; float* out; unsigned char* ws; int ph_lo, ph_hi; };
static_assert(sizeof(Args) == 31 * 8 + 8 + 8 + 8, "no padding bytes in Args");

__global__ void __launch_bounds__(NWAVES * 64, 2) mk_fwd(Args args) {
    extern __shared__ __attribute__((aligned(16))) unsigned char lds_raw[];
    const int lo = args.ph_lo, hi = args.ph_hi;
    XcdBarrier bar;
    { MKFRAME(F0);
      for (int u = F0.tid; u < (LDS_BYTES - MISC_OFF) / 4; u += NWAVES * 64) ((LAS unsigned*)(F0.lds + MISC_OFF))[u] = 0u;
      __syncthreads();
      bar.bar = F0.ctl + CW_BAR; bar.x = 0; bar.st = nullptr;
      if (!MK_SPLIT) bar = xcd_barrier_post(F0.ctl + CW_BAR, F0.MISC + 8); }
#define IN(k) (lo <= (k) && (k) < hi)
#define SEAM(k) do { if (!MK_SPLIT && IN(k) && IN((k) + 1)) xcd_barrier(bar); } while (0)
#define XA_(F) ((bf16_t*)((F).ws + WS_A))
#define QB_(F) ((bf16_t*)(F).out)
#define KB_(F) ((bf16_t*)(F).out + (size_t)T * DM)
#define VB_(F) ((bf16_t*)((F).ws + WS_V))
#define GT_(F) ((bf16_t*)((F).ws + WS_GATES))

    if (IN(0)) { MKFRAME(F); p0_prologue(F); }
    SEAM(0);

    if (IN(1)) {
        { MKFRAME(F);
          pg8::ABPlain g{XA_(F), (const bf16_t*)(F.ws + WS_WIN), DM}; pg8::StaticOrder S; S.init(T, IN_DIM, F.G, (int)blockIdx.x);
          epi::EpiInProj E{QB_(F), KB_(F), VB_(F), (bf16_t*)(F.ws + WS_UP), (bf16_t*)(F.ws + WS_QM), GT_(F), F.in[I_QN], F.in[I_KN], (const float*)(F.ws + WS_ROPE), (const float*)(F.ws + WS_ROPE) + SEQ * 32, F.in[I_BG]};
          pg8::gemm_phase<epi::EpiInProj, pg8::StaticOrder, pg8::ABPlain, true, true>(F.tid, F.lds, g, S, E); }
        WG_BAR();
        { MKFRAME(F);
          pg8::ABPlain g{(const bf16_t*)(F.ws + WS_MEMN), (const bf16_t*)(F.ws + WS_WKV), DM}; pg8::StaticOrder S; S.init(TM, DM, F.G, (int)blockIdx.x);
          epi::EpiMemKV E{(bf16_t*)(F.ws + WS_KM), (bf16_t*)(F.ws + WS_VM), F.in[I_MK], F.in[I_MQ]};
          if (F.G >= 64) pg8::gemm_phase<epi::EpiMemKV, pg8::StaticOrder, pg8::ABPlain, false, true>(F.tid, F.lds, g, S, E); }
        WG_BAR();
    }
    SEAM(1);

    if (IN(2)) {
        { MKFRAME(F);
          float lam;
          { const float a = F.in[I_LQ1][F.lane] * F.in[I_LK1][F.lane], b = F.in[I_LQ2][F.lane] * F.in[I_LK2][F.lane];
            lam = __expf(wave_sum(a)) - __expf(wave_sum(b)) + LAMBDA_INIT; }
          const float* gsub = F.in[I_GSUB];
#pragma unroll 1
          for (int P = F.vcu; P < BATCH * 8 * 16; P += F.G) {
#pragma unroll 1
              for (int s = 0; s < 2; ++s) { const int bh = P >> 4, p = P & 15, qb = s ? 31 - p : p;
                  att::da_unit(F.tid, bh >> 3, bh & 7, qb, QB_(F), KB_(F), VB_(F), XA_(F), lam, gsub, F.lds); }
          } }
        { MKFRAME(F); p2_pool(F); }
        { MKFRAME(F);
#pragma unroll 1
          for (int U = F.vcu; U < BATCH * 4 * 4; U += F.G)
              att::ca_unit(F.tid, U >> 4, (U >> 2) & 3, U & 3, (const bf16_t*)(F.ws + WS_QM), (const bf16_t*)(F.ws + WS_KM), (const bf16_t*)(F.ws + WS_VM), (bf16_t*)(F.ws + WS_OM), F.lds); }
    }
    SEAM(2);

    if (IN(3)) {
        { MKFRAME(F); pg8::ABPlain g{XA_(F), (const bf16_t*)(F.ws + WS_WBA), DM}; pg8::StaticOrder S; S.init(T, DM, F.G, (int)blockIdx.x);
          epi::EpiMerge<0> E{GT_(F), 0, VB_(F)};
          pg8::gemm_phase<epi::EpiMerge<0>, pg8::StaticOrder, pg8::ABPlain, true, true>(F.tid, F.lds, g, S, E); }
        WG_BAR();
        { MKFRAME(F); pg8::ABPlain g{(const bf16_t*)(F.ws + WS_Z), (const bf16_t*)(F.ws + WS_WEFF), 512}; pg8::StaticOrder S; S.init(T, DM, F.G, (int)blockIdx.x);
          epi::EpiMerge<1> E{GT_(F), DM, VB_(F)};
          pg8::gemm_phase<epi::EpiMerge<1>, pg8::StaticOrder, pg8::ABPlain, true, true>(F.tid, F.lds, g, S, E); }
        WG_BAR();
        { MKFRAME(F); pg8::ABPlain g{(const bf16_t*)(F.ws + WS_OM), (const bf16_t*)(F.ws + WS_WBM), 512}; pg8::StaticOrder S; S.init(T, DM, F.G, (int)blockIdx.x);
          epi::EpiMerge<1> E{GT_(F), 2 * DM, VB_(F)};
          pg8::gemm_phase<epi::EpiMerge<1>, pg8::StaticOrder, pg8::ABPlain, true, true>(F.tid, F.lds, g, S, E); }
        WG_BAR();
    }
    SEAM(3);

    if (IN(4)) {
        MKFRAME(F); pg8::ABPlain g{VB_(F), (const bf16_t*)(F.ws + WS_WOUT), DM}; pg8::StaticOrder S; S.init(T, DM, F.G, (int)blockIdx.x);
        epi::EpiOut E{F.in[I_X], F.out, XA_(F)};
        pg8::gemm_phase<epi::EpiOut, pg8::StaticOrder, pg8::ABPlain, true, true>(F.tid, F.lds, g, S, E);
        WG_BAR();
    }
    SEAM(4);

    if (IN(5)) { { MKFRAME(F); p5_router(F); } WG_BAR(); { MKFRAME(F); p5_expert_weights(F); } }
    SEAM(5);

#pragma unroll 1
    for (int hf = 0; hf < 2; ++hf) {
        if (IN(6 + 3 * hf)) {
            MKFRAME(F);
            const unsigned* list = (const unsigned*)(F.ws + WS_LIST) + (size_t)hf * NE * CAP;
            moe_tables(F, hf);
            pg8::ABMoeGU g{XA_(F), (const bf16_t*)(F.ws + WS_WGU), list, DM};
            pg8::MoeOrder S{(const volatile LAS int*)(F.MISC + MI_CNT), (const volatile LAS int*)(F.MISC + MI_CUM), 8, F.G, F.vcu, (int)F.MISC[MI_CUM + NE] * 8};
            epi::EpiGateUp E{list, (const float*)(F.ws + WS_RSTD), F.in[I_BGATE], F.in[I_BUP], (bf16_t*)(F.ws + WS_ACT)};
            pg8::gemm_phase<epi::EpiGateUp, pg8::MoeOrder, pg8::ABMoeGU, true, true>(F.tid, F.lds, g, S, E);
            WG_BAR();
        }
        SEAM(6 + 3 * hf);
        if (IN(7 + 3 * hf)) {
            MKFRAME(F);
            moe_tables(F, hf);
            pg8::ABMoeDown g{(const bf16_t*)(F.ws + WS_ACT), (const bf16_t*)(F.ws + WS_WD), DM};
            pg8::MoeOrder S{(const volatile LAS int*)(F.MISC + MI_CNT), (const volatile LAS int*)(F.MISC + MI_CUM), 4, F.G, F.vcu, (int)F.MISC[MI_CUM + NE] * 4};
            epi::EpiDown E{F.in[I_BDOWN], (bf16_t*)(F.ws + WS_OSLOT)};
            pg8::gemm_phase<epi::EpiDown, pg8::MoeOrder, pg8::ABMoeDown, true, true>(F.tid, F.lds, g, S, E);
            WG_BAR();
        }
        SEAM(7 + 3 * hf);
        if (IN(8 + 3 * hf)) { MKFRAME(F); moe_tables(F, hf); moe_combine(F, hf); }
        if (hf == 0) SEAM(8);
    }
#undef IN
#undef SEAM
}

extern "C" void kernel_launch(void* const* d_in, const int* in_sizes, int n_in, void* d_out, int out_size, void* d_ws, size_t ws_size, hipStream_t stream) {
    static int grid = 0;
    if (grid == 0) {
        if (n_in != 31 || in_sizes[0] != T * DM || out_size != T * DM || ws_size < WS_END) { fprintf(stderr, "kernel_launch: unexpected shapes (n_in %d, in0 %d, out %d, ws %zu)\n", n_in, n_in > 0 ? in_sizes[0] : -1, out_size, ws_size); grid = -1; return; }
        int dev = 0, cus = 0, per_cu = 0;
        if (hipGetDevice(&dev) != hipSuccess || hipDeviceGetAttribute(&cus, hipDeviceAttributeMultiprocessorCount, dev) != hipSuccess) { grid = -1; return; }
        if (hipFuncSetAttribute((const void*)mk_fwd, hipFuncAttributeMaxDynamicSharedMemorySize, LDS_BYTES) != hipSuccess) { fprintf(stderr, "kernel_launch: hipFuncSetAttribute failed\n"); grid = -1; return; }
        if (hipOccupancyMaxActiveBlocksPerMultiprocessor(&per_cu, (const void*)mk_fwd, NWAVES * 64, LDS_BYTES) != hipSuccess || per_cu < 1) fprintf(stderr, "kernel_launch: occupancy query reports %d\n", per_cu);
        (void)hipGetLastError();
        grid = cus;
    }
    if (grid < 0) return;
    (void)hipMemsetAsync((char*)d_ws + WS_CTL, 0, CTL_ZERO_BYTES, stream);
    Args a{};
    for (int i = 0; i < 31; ++i) a.in[i] = (const float*)d_in[i];
    a.out = (float*)d_out; a.ws = (unsigned char*)d_ws;
#if MK_SPLIT
    for (int p = 0; p < N_PHASES; ++p) { a.ph_lo = p; a.ph_hi = p + 1; hipLaunchKernelGGL(mk_fwd, dim3(grid), dim3(NWAVES * 64), LDS_BYTES, stream, a); }
#else
    a.ph_lo = 0; a.ph_hi = N_PHASES;
    hipLaunchKernelGGL(mk_fwd, dim3(grid), dim3(NWAVES * 64), LDS_BYTES, stream, a);
#endif
    const hipError_t le = hipPeekAtLastError();
    if (le != hipSuccess) fprintf(stderr, "kernel_launch: launch failed: %s\n", hipGetErrorName(le));
}
```

```cpp
#include <hip/hip_runtime.h>
#include <cstdio>
#include <cstdint>

#define GAS __attribute__((address_space(1)))
#define LAS __attribute__((address_space(3)))
typedef unsigned short bf16_t;
typedef short bf16x8 __attribute__((ext_vector_type(8)));
typedef short s16x4 __attribute__((ext_vector_type(4)));
typedef float f32x2 __attribute__((ext_vector_type(2)));
typedef float f32x4 __attribute__((ext_vector_type(4)));
typedef float f32x16 __attribute__((ext_vector_type(16)));
typedef unsigned u32x2 __attribute__((ext_vector_type(2)));
typedef unsigned u32x4 __attribute__((ext_vector_type(4)));
typedef __bf16 bf16x2_t __attribute__((ext_vector_type(2)));

constexpr int BATCH = 16, SEQ = 4096, DM = 1024, T = BATCH * SEQ;
constexpr int IN_DIM = 7168, MEMLEN = 256, TM = BATCH * MEMLEN;
constexpr int NE = 32, TOPK = 4, CAP = T;
constexpr float EPS = 1e-6f;
constexpr float LAMBDA_INIT = 0.2f;
constexpr float LOG2E = 1.4426950408889634f;
constexpr float C2 = 0.125f * LOG2E;
constexpr float C3 = 0.08838834764831845f * LOG2E;
constexpr int NWAVES = 8;

constexpr size_t MiB = 1u << 20;
constexpr size_t WS_CTL = 0, CTL_ZERO_BYTES = 1 * MiB;
constexpr size_t WS_WIN = 2 * MiB;
constexpr size_t WS_WIN8 = 8 * MiB;
constexpr size_t WS_WKV = 16 * MiB;
constexpr size_t WS_WCAT = 18 * MiB;
constexpr size_t WS_WOUT = 22 * MiB;
constexpr size_t WS_ROPE = 24 * MiB;
constexpr size_t WS_WR = 25 * MiB;
constexpr size_t WS_MEMN = 26 * MiB;
constexpr size_t WS_KM = 34 * MiB;
constexpr size_t WS_VM = 38 * MiB;
constexpr size_t WS_TSLOT = 42 * MiB;
constexpr size_t WS_TW = 43 * MiB;
constexpr size_t WS_RSTD = 44 * MiB;
constexpr size_t WS_LIST = 46 * MiB;
constexpr size_t WS_RSLOT = 54 * MiB;
constexpr size_t WS_A = 64 * MiB;
constexpr size_t WS_GATES = 320 * MiB;
constexpr size_t WS_V = 704 * MiB;
constexpr size_t WS_UP = 832 * MiB;
constexpr size_t WS_QM = 896 * MiB;
constexpr int BR_LD = 2048, BR_Z = 1024, BR_OM = 1536;
constexpr size_t WS_XN8 = 960 * MiB;
constexpr size_t WS_WGU8 = 192 * MiB;
constexpr size_t WS_WD8 = 256 * MiB;
constexpr size_t WS_HB8 = 288 * MiB;
constexpr size_t WS_ACT8 = 352 * MiB;
constexpr size_t WS_OSLOT = 616 * MiB;
constexpr int PMAX = T * TOPK + NE * 256;
constexpr size_t WS_END = 1024 * MiB;
constexpr float W8_SCALE = 128.0f, ACT_SCALE = 4.0f, OS_SCALE = 16.0f;
static_assert(WS_ACT8 + (size_t)PMAX * DM <= WS_OSLOT && WS_OSLOT + (size_t)PMAX * DM <= WS_END, "moe buffers");
static_assert(WS_LIST + (size_t)NE * CAP * 4 <= WS_RSLOT && WS_RSLOT + (size_t)NE * CAP * 4 <= WS_A, "list");
constexpr int CW_TMO = 0, CW_BAR = 4096, CW_CNT = 8192;

constexpr int RING_BYTES = 131072;
constexpr int WSF_OFF = RING_BYTES;
constexpr int MISC_OFF = WSF_OFF + 2048;
constexpr int LDS_BYTES = 147456;

#define RLX_AGENT __ATOMIC_RELAXED, __HIP_MEMORY_SCOPE_AGENT
#define LDS_WAIT() asm volatile("s_waitcnt lgkmcnt(0)" ::: "memory")
#define VM_WAIT() asm volatile("s_waitcnt vmcnt(0)" ::: "memory")
#define WG_BAR() asm volatile("s_waitcnt vmcnt(0) lgkmcnt(0)\n\ts_barrier" ::: "memory")

__device__ __forceinline__ unsigned cvtpk(float lo, float hi) { f32x2 v = {lo, hi}; bf16x2_t b = __builtin_convertvector(v, bf16x2_t); return __builtin_bit_cast(unsigned, b); }
__device__ __forceinline__ unsigned cvt4_fp8(float a, float b, float c, float d) { int r = __builtin_amdgcn_cvt_pk_fp8_f32(a, b, 0, false); r = __builtin_amdgcn_cvt_pk_fp8_f32(c, d, r, true); return (unsigned)r; }
__device__ __forceinline__ float clamp_fp8(float x) { return __builtin_amdgcn_fmed3f(x, -448.0f, 448.0f); }
__device__ __forceinline__ float bf_lo(unsigned w) { return __uint_as_float(w << 16); }
__device__ __forceinline__ float bf_hi(unsigned w) { return __uint_as_float(w & 0xffff0000u); }
__device__ __forceinline__ float wave_sum(float v) {
#pragma unroll
    for (int o = 1; o < 64; o <<= 1) v += __shfl_xor(v, o);
    return v;
}
__device__ __forceinline__ float fast_sigmoid(float x) { return __builtin_amdgcn_rcpf(1.0f + __builtin_amdgcn_exp2f(-LOG2E * x)); }
namespace pg8 {
constexpr int BM = 256, BK = 64, HALF = 128, HTB = HALF * BK * 2  , STAGE_BYTES = 8 * HTB, NXCD = 8, WGM = 8;

__host__ __device__ __forceinline__ int lds_byte(int r, int c) { const int st = (r >> 4) * 2 + (c >> 5), rr = r & 15, cc = c & 31, ob = rr * 64 + cc * 2; return st * 1024 + (ob ^ (((ob >> 9) & 1) << 5)); }
__host__ __device__ __forceinline__ void stage_rc(int b, int& R, int& C) { const int st = b / 1024, sb = b % 1024, swz = sb ^ (((sb >> 9) & 1) << 5); R = (st >> 1) * 16 + swz / 64; C = (st & 1) * 32 + (swz % 64) / 2; }
__host__ __device__ __forceinline__ int perm32(int rho) { const int n = rho >> 4, i = rho & 15; return 8 * (i >> 2) + 4 * n + (i & 3); }

struct Unit { int pm, pn, e, rb, nvalid; };

struct StaticOrder {
    int nM, nN, nwg, G, c;
    __device__ void init(int M, int N, int G_, int c_) { nM = M / BM; nN = N / BM; nwg = nM * nN; G = G_; c = c_; }
    __device__ bool next(int i, Unit& u) const {
        const long L = (long)i * G + c; if (L >= nwg) return false;
        int wgid = (int)L; { const int q = nwg / NXCD, r = nwg % NXCD, xcd = wgid % NXCD, off = wgid / NXCD; wgid = (xcd < r ? xcd * (q + 1) : r * (q + 1) + (xcd - r) * q) + off; }
        const int nig = WGM * nN, gid = wgid / nig, fm = gid * WGM, gsz = (nM - fm) < WGM ? (nM - fm) : WGM;
        u.pm = fm + ((wgid % nig) % gsz); u.pn = (wgid % nig) / gsz; u.e = 0; u.rb = 0; u.nvalid = 256; return true;
    }
};

struct ABPlain {
    static constexpr bool GATHER = false, FP8 = false;
    const bf16_t* A; const bf16_t* Bt; int K;
    __device__ __forceinline__ const char* a_base(const Unit& u) const { return (const char*)A + (size_t)u.pm * BM * K * 2; }
    __device__ __forceinline__ const char* b_base(const Unit& u) const { return (const char*)Bt + (size_t)u.pn * BM * K * 2; }
    __device__ __forceinline__ unsigned a_off(const Unit&, int r, int c) const { return (unsigned)(r * K + c) * 2u; }
};

struct ABPlain8 {
    static constexpr bool GATHER = false, FP8 = true;
    const bf16_t* A; const bf16_t* Bt; int K;
    __device__ __forceinline__ const char* a_base(const Unit& u) const { return (const char*)A + (size_t)u.pm * BM * K * 2; }
    __device__ __forceinline__ const char* b_base(const Unit& u) const { return (const char*)Bt + (size_t)u.pn * BM * K * 2; }
    __device__ __forceinline__ unsigned a_off(const Unit&, int r, int c) const { return (unsigned)(r * K + c) * 2u; }
};

typedef int v8i_ __attribute__((ext_vector_type(8))); typedef int v4i_ __attribute__((ext_vector_type(4)));
template <class Epi, class Sched, class AB, bool ALIGN_EPI, bool SP2>
__device__ __forceinline__ void gemm_phase(const int tid, LAS unsigned char* lds, const AB& g, const Sched& S, const Epi& E) {
    static_assert(SP2, "only the SP2 loop is kept");
    const int wid = __builtin_amdgcn_readfirstlane(tid >> 6), lane = tid & 63, wr = wid >> 2, wc = wid & 3, fr = lane & 15, fq = lane >> 4;
    const int K = g.K, nt = K / BK;
    unsigned voffB[2]; int rA[2], cA_[2];
#pragma unroll
    for (int i = 0; i < 2; ++i) { int R, C; stage_rc(tid * 16 + i * 8192, R, C); const int Rb = Epi::PERM ? ((R & ~31) + perm32(R & 31)) : R;
        rA[i] = R; cA_[i] = C; voffB[i] = (unsigned)(Rb * K + C) * 2u; }
    const size_t kstep = (size_t)(BK * 2);
    const size_t hstep = (size_t)HALF * K * 2;
    const unsigned ldsw = (unsigned)wid * 1024u;
    const int aoff = lds_byte(wr * 64 + fr, fq * 8), boff = lds_byte(wc * 32 + fr, fq * 8);
#define PG8_SA(b, h) (((b) * 2 + (h)) * HTB)
#define PG8_SB(b, h) ((4 + (b) * 2 + (h)) * HTB)
#define PG8_STAGE(bufoff, gbase, voff) do { _Pragma("unroll") for (int _i = 0; _i < 2; ++_i) \
        __builtin_amdgcn_global_load_lds((const unsigned*)((const char*)(gbase) + (voff)[_i]), (LAS unsigned*)(lds + (bufoff) + ldsw + _i * 8192), 16, 0, 0); } while (0)
#define PG8_LDA(dst, b, h) do { _Pragma("unroll") for (int m = 0; m < 4; ++m) { const v4i_ x0_ = *(const LAS v4i_*)(lds + PG8_SA(b, h) + aoff + m * 2048), x1_ = *(const LAS v4i_*)(lds + PG8_SA(b, h) + aoff + m * 2048 + 1024); \
        dst[m] = __builtin_shufflevector(x0_, x1_, 0, 1, 2, 3, 4, 5, 6, 7); } } while (0)
#define PG8_LDB(dst, b, h) do { _Pragma("unroll") for (int n = 0; n < 2; ++n) { const v4i_ x0_ = *(const LAS v4i_*)(lds + PG8_SB(b, h) + boff + n * 2048), x1_ = *(const LAS v4i_*)(lds + PG8_SB(b, h) + boff + n * 2048 + 1024); \
        dst[n] = __builtin_shufflevector(x0_, x1_, 0, 1, 2, 3, 4, 5, 6, 7); } } while (0)
#define PG8_MMA(ai, bj, At, Bt) do { __builtin_amdgcn_s_setprio(1); _Pragma("unroll") for (int m = 0; m < 4; ++m) _Pragma("unroll") for (int n = 0; n < 2; ++n) { \
        if constexpr (AB::FP8) { asm volatile("v_mfma_f32_16x16x128_f8f6f4 %0, %1, %2, %0" : "+v"(acc[ai][bj][m][n]) : "v"(Bt[n]), "v"(At[m])); } \
        else { acc[ai][bj][m][n] = __builtin_amdgcn_mfma_f32_16x16x32_bf16(__builtin_bit_cast(bf16x8, __builtin_shufflevector(Bt[n], Bt[n], 0, 1, 2, 3)), __builtin_bit_cast(bf16x8, __builtin_shufflevector(At[m], At[m], 0, 1, 2, 3)), acc[ai][bj][m][n], 0, 0, 0); \
               acc[ai][bj][m][n] = __builtin_amdgcn_mfma_f32_16x16x32_bf16(__builtin_bit_cast(bf16x8, __builtin_shufflevector(Bt[n], Bt[n], 4, 5, 6, 7)), __builtin_bit_cast(bf16x8, __builtin_shufflevector(At[m], At[m], 4, 5, 6, 7)), acc[ai][bj][m][n], 0, 0, 0); } } \
        __builtin_amdgcn_s_setprio(0); } while (0)
#define PG8_WAIT_V(n) asm volatile("s_waitcnt vmcnt(" #n ")" ::: "memory")
#define PG8_WAIT_L(n) asm volatile("s_waitcnt lgkmcnt(" #n ")" ::: "memory")
#define PG8_BAR __builtin_amdgcn_s_barrier()
#define PG8_SCHED __builtin_amdgcn_sched_barrier(0)
    Unit cur, nxt; int ui = 0;
    if (!S.next(0, cur)) return;
    f32x4 acc[2][2][4][2];
#pragma unroll
    for (int a = 0; a < 2; ++a)
#pragma unroll
        for (int b = 0; b < 2; ++b)
#pragma unroll
            for (int m = 0; m < 4; ++m)
#pragma unroll
                for (int n = 0; n < 2; ++n) acc[a][b][m][n] = (f32x4){0.f, 0.f, 0.f, 0.f};
    v8i_ At[4], B0[2], B1[2];
    unsigned vA0[2], vA1[2], tk[4] = {0u, 0u, 0u, 0u};
#pragma unroll
    for (int i = 0; i < 2; ++i) { vA0[i] = g.a_off(cur, rA[i], cA_[i]); vA1[i] = g.a_off(cur, HALF + rA[i], cA_[i]); }
    const char* cA = g.a_base(cur); const char* cB = g.b_base(cur);
    PG8_STAGE(PG8_SB(0, 0), cB, voffB); PG8_STAGE(PG8_SB(0, 1), cB + hstep, voffB); PG8_STAGE(PG8_SA(0, 0), cA, vA0); PG8_STAGE(PG8_SA(0, 1), cA, vA1);
    if (wr == 1) PG8_BAR;
    PG8_WAIT_V(2); PG8_BAR;
    PG8_STAGE(PG8_SB(1, 0), cB + kstep, voffB); PG8_STAGE(PG8_SA(1, 0), cA + kstep, vA0); PG8_STAGE(PG8_SB(1, 1), cB + hstep + kstep, voffB);
    PG8_WAIT_V(6); PG8_BAR;
    for (;;) {
        const bool has_next = S.next(ui + 1, nxt);
        const char* nA = has_next ? g.a_base(nxt) : cA; const char* nB = has_next ? g.b_base(nxt) : cB;
        if constexpr (AB::GATHER) {
            if (has_next) {
#pragma unroll
                for (int i = 0; i < 2; ++i) {
                    asm volatile("global_load_dword %0, %1, off" : "=v"(tk[i]) : "v"(g.tok_ptr(nxt, rA[i])) : "memory");
                    asm volatile("global_load_dword %0, %1, off" : "=v"(tk[2 + i]) : "v"(g.tok_ptr(nxt, HALF + rA[i])) : "memory");
                }
            }
        }
        for (int t = 0; t < nt; t += 2) {
            if constexpr (Epi::HOOKS) { if (t == Epi::HOOK1 || t == Epi::HOOK2) E.hook(acc, cur, t, wr, wc, fr, fq); }
            const bool last = (t == nt - 2);
            const char* a1 = cA + (size_t)(t + 1) * kstep;
            const char* a2 = last ? nA : cA + (size_t)(t + 2) * kstep; const char* b2 = last ? nB : cB + (size_t)(t + 2) * kstep;
            const char* a3 = a2 + kstep; const char* b3 = b2 + kstep;
            unsigned w0[2], w1[2];
#pragma unroll
            for (int i = 0; i < 2; ++i) { w0[i] = vA0[i]; w1[i] = vA1[i]; }
            if constexpr (AB::GATHER) {
                if (last && has_next) {
                    asm volatile("s_waitcnt vmcnt(8)" : "+v"(tk[0]), "+v"(tk[1]), "+v"(tk[2]), "+v"(tk[3]) :: "memory");
#pragma unroll
                    for (int i = 0; i < 2; ++i) { w0[i] = g.off_from_tok(tk[i], cA_[i]); w1[i] = g.off_from_tok(tk[2 + i], cA_[i]); }
                }
            }
            PG8_LDB(B0, 0, 0); PG8_LDB(B1, 0, 1); PG8_SCHED; PG8_LDA(At, 0, 0); PG8_STAGE(PG8_SA(1, 1), a1, vA1);
            PG8_WAIT_V(8); PG8_WAIT_L(0); PG8_BAR; PG8_MMA(0, 0, At, B0); PG8_MMA(0, 1, At, B1); PG8_BAR; PG8_SCHED;
            PG8_LDA(At, 0, 1); PG8_STAGE(PG8_SB(0, 0), b2, voffB); PG8_STAGE(PG8_SB(0, 1), b2 + hstep, voffB); PG8_STAGE(PG8_SA(0, 0), a2, w0);
            PG8_WAIT_V(8); PG8_WAIT_L(0); PG8_BAR; PG8_MMA(1, 0, At, B0); PG8_MMA(1, 1, At, B1); PG8_BAR; PG8_SCHED;
            PG8_LDB(B0, 1, 0); PG8_LDB(B1, 1, 1); PG8_SCHED; PG8_LDA(At, 1, 0); PG8_STAGE(PG8_SA(0, 1), a2, w1);
            PG8_WAIT_V(8); PG8_WAIT_L(0); PG8_BAR; PG8_MMA(0, 0, At, B0); PG8_MMA(0, 1, At, B1); PG8_BAR; PG8_SCHED;
            PG8_LDA(At, 1, 1); PG8_STAGE(PG8_SB(1, 0), b3, voffB); PG8_STAGE(PG8_SB(1, 1), b3 + hstep, voffB); PG8_STAGE(PG8_SA(1, 0), a3, w0);
            PG8_WAIT_V(8); PG8_WAIT_L(0); PG8_BAR; PG8_MMA(1, 0, At, B0); PG8_MMA(1, 1, At, B1); PG8_BAR; PG8_SCHED;
        }
        if constexpr (ALIGN_EPI) { if (wr == 0) PG8_BAR; }
        if constexpr (AB::FP8) asm volatile("s_nop 15\n\ts_nop 15\n\ts_nop 15" ::: "memory");
        if constexpr (!Epi::AFTER_DRAIN) { E(acc, cur, wr, wc, fr, fq); }
        if (!has_next) break;
#pragma unroll
        for (int a = 0; a < 2; ++a)
#pragma unroll
            for (int b = 0; b < 2; ++b)
#pragma unroll
                for (int m = 0; m < 4; ++m)
#pragma unroll
                    for (int n = 0; n < 2; ++n) acc[a][b][m][n] = (f32x4){0.f, 0.f, 0.f, 0.f};
        cur = nxt; cA = nA; cB = nB; ++ui;
        if constexpr (AB::GATHER) {
#pragma unroll
            for (int i = 0; i < 2; ++i) { vA0[i] = g.off_from_tok(tk[i], cA_[i]); vA1[i] = g.off_from_tok(tk[2 + i], cA_[i]); }
        }
        if constexpr (ALIGN_EPI) { if (wr == 1) PG8_BAR; }
    }
    PG8_WAIT_V(0);
    if constexpr (!ALIGN_EPI) { if (wr == 0) PG8_BAR; }
    PG8_BAR;
    if constexpr (Epi::AFTER_DRAIN) { E.fused(acc, cur, wr, wc, fr, fq, lds, wid, lane); }
#undef PG8_SA
#undef PG8_SB
#undef PG8_STAGE
#undef PG8_LDA
#undef PG8_LDB
#undef PG8_MMA
#undef PG8_WAIT_V
#undef PG8_WAIT_L
#undef PG8_BAR
#undef PG8_SCHED
}
}
namespace epi {
using pg8::Unit; using pg8::HALF; using pg8::BM;
typedef f32x4 Acc[2][2][4][2];

__device__ __forceinline__ u32x4 pack8(const f32x4& a, const f32x4& b) { u32x4 w; w.x = cvtpk(a[0], a[1]); w.y = cvtpk(a[2], a[3]); w.z = cvtpk(b[0], b[1]); w.w = cvtpk(b[2], b[3]); return w; }

__device__ __forceinline__ void store_plain(const Acc& acc, bf16_t* O, int ld, int col0, int row0, float sc) {
#pragma unroll
    for (int ai = 0; ai < 2; ++ai)
#pragma unroll
        for (int m = 0; m < 4; ++m) { bf16_t* rp = O + (size_t)(row0 + ai * HALF + m * 16) * ld + col0;
#pragma unroll
            for (int bj = 0; bj < 2; ++bj) *(u32x4*)(rp + bj * HALF) = pack8(acc[ai][bj][m][0] * sc, acc[ai][bj][m][1] * sc); }
}
struct EpiInProj {
    static constexpr bool PERM = true, AFTER_DRAIN = false, HOOKS = false;
    bf16_t *Q, *Kk, *V, *UP, *QM, *G; const float *qn, *kn, *cs, *sn, *bg; int mode; float asc;
    __device__ __forceinline__ void operator()(const Acc& acc_in, const Unit& u, int wr, int wc, int fr, int fq) const {
        const int pn = (mode == 0) ? (u.pn < 8 ? u.pn : u.pn + 4) : (u.pn < 4 ? u.pn + 8 : u.pn + 10);
        const int row0 = u.pm * BM + wr * 64 + fr;
        const Acc& acc = acc_in;
        if (pn < 8) {
            const bool isq = pn < 4; bf16_t* O = isq ? Q : Kk; const float* gn = isq ? qn : kn; const float sc = isq ? C2 : 1.0f;
            const int ct = (isq ? pn : pn - 4) * 256 + wc * 64 + 8 * fq;
            f32x4 g[2][2];
#pragma unroll
            for (int bj = 0; bj < 2; ++bj)
#pragma unroll
                for (int n = 0; n < 2; ++n) g[bj][n] = *(const f32x4*)(gn + 32 * bj + 8 * fq + 4 * n);
#pragma unroll
            for (int ai = 0; ai < 2; ++ai)
#pragma unroll
                for (int m = 0; m < 4; ++m) {
                    const int row = row0 + ai * HALF + m * 16; const int pos = row & (SEQ - 1);
                    float ss = 0.f;
#pragma unroll
                    for (int bj = 0; bj < 2; ++bj)
#pragma unroll
                        for (int n = 0; n < 2; ++n) { const f32x4 x = acc[ai][bj][m][n]; ss += (x[0] * x[0] + x[1] * x[1]) + (x[2] * x[2] + x[3] * x[3]); }
                    ss += __shfl_xor(ss, 16); ss += __shfl_xor(ss, 32);
                    const float rstd = __builtin_amdgcn_rsqf(ss * (1.0f / 64.0f) + EPS) * sc;
                    f32x4 o1[2], o2[2];
#pragma unroll
                    for (int n = 0; n < 2; ++n) {
                        const f32x4 c = *(const f32x4*)(cs + pos * 32 + 8 * fq + 4 * n), s = *(const f32x4*)(sn + pos * 32 + 8 * fq + 4 * n);
                        const f32x4 t1 = acc[ai][0][m][n] * rstd * g[0][n], t2 = acc[ai][1][m][n] * rstd * g[1][n];
                        o1[n] = t1 * c - t2 * s; o2[n] = t2 * c + t1 * s;
                    }
                    bf16_t* rp = O + (size_t)row * DM + ct;
                    *(u32x4*)(rp) = pack8(o1[0], o1[1]); *(u32x4*)(rp + 32) = pack8(o2[0], o2[1]);
                }
        } else if (pn < 12) { store_plain(acc, V, DM, (pn - 8) * 256 + wc * 32 + 8 * fq, row0, asc);
        } else if (pn < 14) { store_plain(acc, UP, 512, (pn - 12) * 256 + wc * 32 + 8 * fq, row0, asc);
        } else if (pn < 16) { store_plain(acc, QM, 512, (pn - 14) * 256 + wc * 32 + 8 * fq, row0, asc);
        } else {
            const int col0 = (pn - 16) * 256 + wc * 32 + 8 * fq;
            f32x4 bv[2][2];
#pragma unroll
            for (int bj = 0; bj < 2; ++bj)
#pragma unroll
                for (int n = 0; n < 2; ++n) bv[bj][n] = *(const f32x4*)(bg + col0 + bj * HALF + 4 * n) * (-LOG2E);
            const float sce = -LOG2E * asc;
#pragma unroll
            for (int ai = 0; ai < 2; ++ai)
#pragma unroll
                for (int m = 0; m < 4; ++m) { bf16_t* rp = G + (size_t)(row0 + ai * HALF + m * 16) * 3072 + col0;
#pragma unroll
                    for (int bj = 0; bj < 2; ++bj) { f32x4 a, b;
#pragma unroll
                        for (int e = 0; e < 4; ++e) { a[e] = __builtin_amdgcn_rcpf(1.0f + __builtin_amdgcn_exp2f(fmaf(acc[ai][bj][m][0][e], sce, bv[bj][0][e])));
                                                      b[e] = __builtin_amdgcn_rcpf(1.0f + __builtin_amdgcn_exp2f(fmaf(acc[ai][bj][m][1][e], sce, bv[bj][1][e]))); }
                        *(u32x4*)(rp + bj * HALF) = pack8(a, b); } }
        }
    }
};

struct EpiMemKV {
    static constexpr bool PERM = true, AFTER_DRAIN = true, HOOKS = false;
    bf16_t *KM, *VM; const float *mk, *mq;
    __device__ __forceinline__ void fused(const Acc& acc, const Unit& u, int wr, int wc, int fr, int fq, LAS unsigned char* lds, int wid, int lane) const {
        const int pn = u.pn;
        if (pn < 2) {
            LAS float* P = (LAS float*)lds;
#pragma unroll
            for (int ai = 0; ai < 2; ++ai)
#pragma unroll
                for (int m = 0; m < 4; ++m)
#pragma unroll
                    for (int bj = 0; bj < 2; ++bj) {
                        float ss = 0.f;
#pragma unroll
                        for (int n = 0; n < 2; ++n) { const f32x4 x = acc[ai][bj][m][n]; ss += (x[0] * x[0] + x[1] * x[1]) + (x[2] * x[2] + x[3] * x[3]); }
                        ss += __shfl_xor(ss, 16); ss += __shfl_xor(ss, 32);
                        if (fq == 0) P[((ai * HALF + wr * 64 + m * 16 + fr) * 2 + bj) * 4 + wc] = ss;
                    }
            WG_BAR();
            const int d0 = wc * 32 + 8 * fq;
            f32x4 gn[2];
#pragma unroll
            for (int n = 0; n < 2; ++n) { const f32x4 a = *(const f32x4*)(mk + d0 + 4 * n), b = *(const f32x4*)(mq + d0 + 4 * n); gn[n] = a * b * C3; }
#pragma unroll
            for (int ai = 0; ai < 2; ++ai)
#pragma unroll
                for (int m = 0; m < 4; ++m) { const int rl = ai * HALF + wr * 64 + m * 16 + fr;
#pragma unroll
                    for (int bj = 0; bj < 2; ++bj) {
                        const f32x4 p4 = *(const LAS f32x4*)(P + (rl * 2 + bj) * 4);
                        const float rstd = __builtin_amdgcn_rsqf(((p4[0] + p4[1]) + (p4[2] + p4[3])) * (1.0f / 128.0f) + EPS);
                        const f32x4 a = acc[ai][bj][m][0] * rstd * gn[0], b = acc[ai][bj][m][1] * rstd * gn[1];
                        *(u32x4*)(KM + (size_t)(u.pm * BM + rl) * 512 + (2 * pn + bj) * 128 + d0) = pack8(a, b);
                    } }
        } else {
            const int col0 = (pn - 2) * 256 + wc * 32 + 8 * fq;
#pragma unroll
            for (int ai = 0; ai < 2; ++ai)
#pragma unroll
                for (int m = 0; m < 4; ++m) { bf16_t* rp = VM + (size_t)(u.pm * BM + ai * HALF + wr * 64 + m * 16 + fr) * 512 + col0;
#pragma unroll
                    for (int bj = 0; bj < 2; ++bj) *(u32x4*)(rp + bj * HALF) = pack8(acc[ai][bj][m][0], acc[ai][bj][m][1]); }
        }
    }
};

struct EpiMerge3 {
    static constexpr bool PERM = true, AFTER_DRAIN = false, HOOKS = true; static constexpr int HOOK1 = 16, HOOK2 = 24;
    const bf16_t* G; bf16_t* M;
    __device__ __forceinline__ void hook(Acc& acc, const Unit& u, int t, int wr, int wc, int fr, int fq) const {
        int row0 = u.pm * BM + wr * 64 + fr; asm volatile("" : "+v"(row0));
        const int col0 = u.pn * BM + wc * 32 + 8 * fq; const int ga = (t == HOOK1) ? 0 : DM, gb = ga + DM;
#pragma unroll
        for (int ai = 0; ai < 2; ++ai)
#pragma unroll
            for (int m = 0; m < 4; ++m) { const size_t row = (size_t)(row0 + ai * HALF + m * 16);
#pragma unroll
                for (int bj = 0; bj < 2; ++bj) {
                    const u32x4 na = *(const u32x4*)(G + row * 3072 + ga + col0 + bj * HALF), nb = *(const u32x4*)(G + row * 3072 + gb + col0 + bj * HALF);
                    f32x4& a = acc[ai][bj][m][0]; f32x4& b = acc[ai][bj][m][1];
                    a[0] *= bf_lo(na.x) * __builtin_amdgcn_rcpf(bf_lo(nb.x)); a[1] *= bf_hi(na.x) * __builtin_amdgcn_rcpf(bf_hi(nb.x)); a[2] *= bf_lo(na.y) * __builtin_amdgcn_rcpf(bf_lo(nb.y)); a[3] *= bf_hi(na.y) * __builtin_amdgcn_rcpf(bf_hi(nb.y));
                    b[0] *= bf_lo(na.z) * __builtin_amdgcn_rcpf(bf_lo(nb.z)); b[1] *= bf_hi(na.z) * __builtin_amdgcn_rcpf(bf_hi(nb.z)); b[2] *= bf_lo(na.w) * __builtin_amdgcn_rcpf(bf_lo(nb.w)); b[3] *= bf_hi(na.w) * __builtin_amdgcn_rcpf(bf_hi(nb.w));
                }
                if (m == 3) asm volatile("" ::: "memory"); }
    }
    __device__ __forceinline__ void operator()(const Acc& acc, const Unit& u, int wr, int wc, int fr, int fq) const {
        const int row0 = u.pm * BM + wr * 64 + fr, col0 = u.pn * BM + wc * 32 + 8 * fq;
#pragma unroll
        for (int ai = 0; ai < 2; ++ai)
#pragma unroll
            for (int m = 0; m < 4; ++m) { const size_t row = (size_t)(row0 + ai * HALF + m * 16);
#pragma unroll
                for (int bj = 0; bj < 2; ++bj) {
                    const u32x4 gw = *(const u32x4*)(G + row * 3072 + 2 * DM + col0 + bj * HALF);
                    f32x4 a = acc[ai][bj][m][0], b = acc[ai][bj][m][1];
                    a[0] *= bf_lo(gw.x); a[1] *= bf_hi(gw.x); a[2] *= bf_lo(gw.y); a[3] *= bf_hi(gw.y);
                    b[0] *= bf_lo(gw.z); b[1] *= bf_hi(gw.z); b[2] *= bf_lo(gw.w); b[3] *= bf_hi(gw.w);
                    *(u32x4*)(M + row * DM + col0 + bj * HALF) = pack8(a, b);
                } }
    }
};

struct EpiOut {
    static constexpr bool PERM = true, AFTER_DRAIN = false, HOOKS = false;
    const float* X; bf16_t* HB; unsigned char* HB8;
    __device__ __forceinline__ void operator()(const Acc& acc, const Unit& u, int wr, int wc, int fr, int fq) const {
        const int row0 = u.pm * BM + wr * 64 + fr, col0 = u.pn * BM + wc * 32 + 8 * fq;
#pragma unroll
        for (int ai = 0; ai < 2; ++ai)
#pragma unroll
            for (int m = 0; m < 4; ++m) { const size_t off = (size_t)(row0 + ai * HALF + m * 16) * DM + col0;
#pragma unroll
                for (int bj = 0; bj < 2; ++bj) {
                    const f32x4 a = acc[ai][bj][m][0] + *(const f32x4*)(X + off + bj * HALF), b = acc[ai][bj][m][1] + *(const f32x4*)(X + off + bj * HALF + 4);
                    *(u32x4*)(HB + off + bj * HALF) = pack8(a, b);
                    u32x2 q; q.x = cvt4_fp8(clamp_fp8(a[0]), clamp_fp8(a[1]), clamp_fp8(a[2]), clamp_fp8(a[3])); q.y = cvt4_fp8(clamp_fp8(b[0]), clamp_fp8(b[1]), clamp_fp8(b[2]), clamp_fp8(b[3])); *(u32x2*)(HB8 + off + bj * HALF) = q;
                } }
    }
};

struct EpiGateUp {
    static constexpr bool PERM = true, AFTER_DRAIN = false, HOOKS = false;
    const float* rslot; const float *bgate, *bup; unsigned char* ACT;
    __device__ __forceinline__ void operator()(const Acc& acc, const Unit& u, int wr, int wc, int fr, int fq) const {
        const int cole = u.pn * 128 + wc * 32 + 8 * fq;
        f32x4 bgv[2], buv[2];
#pragma unroll
        for (int n = 0; n < 2; ++n) { bgv[n] = *(const f32x4*)(bgate + u.e * DM + cole + 4 * n); buv[n] = *(const f32x4*)(bup + u.e * DM + cole + 4 * n) * ACT_SCALE + ACT_SCALE; }
        const float* le = rslot + (size_t)u.e * CAP + u.rb * 256;
        int nv = u.nvalid; asm volatile("" : "+s"(nv));
#pragma unroll
        for (int ai = 0; ai < 2; ++ai)
#pragma unroll
            for (int m = 0; m < 4; ++m) {
                const int rl = ai * HALF + wr * 64 + m * 16 + fr; const int sl = rl < nv ? rl : nv - 1;
                const float rs = le[sl] * (1.0f / W8_SCALE), rs4 = rs * ACT_SCALE;
                f32x4 o[2];
#pragma unroll
                for (int n = 0; n < 2; ++n)
#pragma unroll
                    for (int e = 0; e < 4; e += 2) {
                        const f32x2 ag = {acc[ai][0][m][n][e], acc[ai][0][m][n][e + 1]}, au = {acc[ai][1][m][n][e], acc[ai][1][m][n][e + 1]};
                        const f32x2 bg2 = {bgv[n][e], bgv[n][e + 1]}, bu2 = {buv[n][e], buv[n][e + 1]};
                        f32x2 g = ag * rs + bg2; g.x = fminf(g.x, 7.0f); g.y = fminf(g.y, 7.0f);
                        f32x2 up = au * rs4 + bu2; up.x = __builtin_amdgcn_fmed3f(up.x, -6.0f * ACT_SCALE, 8.0f * ACT_SCALE); up.y = __builtin_amdgcn_fmed3f(up.y, -6.0f * ACT_SCALE, 8.0f * ACT_SCALE);
                        const f32x2 xe = g * (-1.702f * LOG2E); f32x2 d; d.x = __builtin_amdgcn_exp2f(xe.x); d.y = __builtin_amdgcn_exp2f(xe.y); d = d + 1.0f;
                        f32x2 r; r.x = __builtin_amdgcn_rcpf(d.x); r.y = __builtin_amdgcn_rcpf(d.y);
                        const f32x2 a2 = (g * up) * r; o[n][e] = a2.x; o[n][e + 1] = a2.y;
                    }
                u32x2 q; q.x = cvt4_fp8(o[0][0], o[0][1], o[0][2], o[0][3]); q.y = cvt4_fp8(o[1][0], o[1][1], o[1][2], o[1][3]);
                *(u32x2*)(ACT + (size_t)(u.pm * BM + rl) * DM + cole) = q;
            }
    }
};

struct EpiDown {
    static constexpr bool PERM = true, AFTER_DRAIN = false, HOOKS = false;
    const float* bdown; unsigned char* OS;
    __device__ __forceinline__ void operator()(const Acc& acc, const Unit& u, int wr, int wc, int fr, int fq) const {
        const int col0 = u.pn * BM + wc * 32 + 8 * fq;
        f32x4 bv[2][2];
#pragma unroll
        for (int bj = 0; bj < 2; ++bj)
#pragma unroll
            for (int n = 0; n < 2; ++n) bv[bj][n] = *(const f32x4*)(bdown + u.e * DM + col0 + bj * HALF + 4 * n);
#pragma unroll
        for (int ai = 0; ai < 2; ++ai)
#pragma unroll
            for (int m = 0; m < 4; ++m) { unsigned char* rp = OS + (size_t)(u.pm * BM + ai * HALF + wr * 64 + m * 16 + fr) * DM + col0;
#pragma unroll
                for (int bj = 0; bj < 2; ++bj) { const f32x4 a = (acc[ai][bj][m][0] * (1.0f / (W8_SCALE * ACT_SCALE)) + bv[bj][0]) * OS_SCALE, b = (acc[ai][bj][m][1] * (1.0f / (W8_SCALE * ACT_SCALE)) + bv[bj][1]) * OS_SCALE;
                    u32x2 q; q.x = cvt4_fp8(clamp_fp8(a[0]), clamp_fp8(a[1]), clamp_fp8(a[2]), clamp_fp8(a[3])); q.y = cvt4_fp8(clamp_fp8(b[0]), clamp_fp8(b[1]), clamp_fp8(b[2]), clamp_fp8(b[3])); *(u32x2*)(rp + bj * HALF) = q; } }
    }
};
}

namespace pg8 {
struct ABMoeGU {
    static constexpr bool GATHER = true, FP8 = true;
    const bf16_t* A; const bf16_t* Bt; const unsigned* list; int K;
    __device__ __forceinline__ const char* a_base(const Unit&) const { return (const char*)A; }
    __device__ __forceinline__ const char* b_base(const Unit& u) const { return (const char*)Bt + ((size_t)u.e * 2048 + (size_t)u.pn * BM) * K * 2; }
    __device__ __forceinline__ const unsigned* tok_ptr(const Unit& u, int r) const { const int sl = r < u.nvalid ? r : u.nvalid - 1; return list + (size_t)u.e * CAP + u.rb * 256 + sl; }
    __device__ __forceinline__ unsigned off_from_tok(unsigned tok, int c) const { return (tok * (unsigned)K + (unsigned)c) * 2u; }
    __device__ __forceinline__ unsigned a_off(const Unit& u, int r, int c) const { return off_from_tok(*tok_ptr(u, r), c); }
};
struct ABMoeDown {
    static constexpr bool GATHER = false, FP8 = true;
    const bf16_t* A; const bf16_t* Bt; int K;
    __device__ __forceinline__ const char* a_base(const Unit& u) const { return (const char*)A + (size_t)u.pm * BM * K * 2; }
    __device__ __forceinline__ const char* b_base(const Unit& u) const { return (const char*)Bt + ((size_t)u.e * DM + (size_t)u.pn * BM) * K * 2; }
    __device__ __forceinline__ unsigned a_off(const Unit&, int r, int c) const { return (unsigned)(r * K + c) * 2u; }
};
struct MoeOrder {
    const volatile LAS int* cnt; const volatile LAS int* cum; const volatile LAS int* rb2e; int nN, G, c, total;
    __device__ __forceinline__ bool next(int i, Unit& u) const {
        const long L = (long)i * G + c; if (L >= total) return false;
        const int rbg = (int)(L / nN); u.pn = (int)(L % nN);
        const int e = __builtin_amdgcn_readfirstlane(rb2e[rbg]);
        u.e = e; u.rb = rbg - __builtin_amdgcn_readfirstlane(cum[e]); u.pm = rbg; const int left = __builtin_amdgcn_readfirstlane(cnt[e]) - u.rb * 256; u.nvalid = left < 256 ? left : 256; return true;
    }
};
}
namespace att {
#define MFMA32(a, b, c) __builtin_amdgcn_mfma_f32_32x32x16_bf16((a), (b), (c), 0, 0, 0)
__device__ __forceinline__ int crow(int r, int hi) { return (r & 3) + 8 * (r >> 2) + 4 * hi; }
typedef short v4i16_t __attribute__((ext_vector_type(4)));
__device__ __forceinline__ s16x4 vtr(const LAS char* p) { return __builtin_bit_cast(s16x4, __builtin_amdgcn_ds_read_tr16_b64_v4i16((LAS v4i16_t*)p)); }

template <int ND0> __device__ __forceinline__ void qk_tile(f32x16& p0, f32x16& p1, const LAS char* kb, const bf16x8* qr) {
    f32x16 z = {0.f, 0.f, 0.f, 0.f, 0.f, 0.f, 0.f, 0.f, 0.f, 0.f, 0.f, 0.f, 0.f, 0.f, 0.f, 0.f};
    p0 = z; p1 = z;
#pragma unroll
    for (int d0 = 0; d0 < ND0; ++d0) {
        const bf16x8 b0 = *(const LAS bf16x8*)(kb + d0 * 2048), b1 = *(const LAS bf16x8*)(kb + d0 * 2048 + 512);
        p0 = MFMA32(b0, qr[d0], p0); p1 = MFMA32(b1, qr[d0], p1);
    }
}
__device__ __forceinline__ void softmax_pv(f32x16& p0, f32x16& p1, float& mrow, float& lrow, f32x16 (&o)[4], const LAS char* vp, LAS float* wsf, int r32, int hi) {
    float a = fmaxf(p0[0], p1[0]);
#pragma unroll
    for (int r = 1; r < 16; ++r) a = fmaxf(a, fmaxf(p0[r], p1[r]));
    { auto rr = __builtin_amdgcn_permlane32_swap(__float_as_uint(a), __float_as_uint(a), false, false); a = fmaxf(__uint_as_float(rr[0]), __uint_as_float(rr[1])); }
    const float mnew = fmaxf(mrow, a);
    if (__any(mnew > mrow)) {
        const float f = __builtin_amdgcn_exp2f(mrow - mnew);
        lrow *= f;
        if (hi == 0) wsf[r32] = f;
        LDS_WAIT();
#pragma unroll
        for (int g = 0; g < 4; ++g) { const f32x4 f4 = *(const LAS f32x4*)(wsf + 8 * g + 4 * hi);
#pragma unroll
            for (int d = 0; d < 4; ++d) { o[d][4 * g + 0] *= f4[0]; o[d][4 * g + 1] *= f4[1]; o[d][4 * g + 2] *= f4[2]; o[d][4 * g + 3] *= f4[3]; } }
        mrow = mnew;
    }
    float s = 0.f;
#pragma unroll
    for (int r = 0; r < 16; ++r) { p0[r] = __builtin_amdgcn_exp2f(p0[r] - mrow); p1[r] = __builtin_amdgcn_exp2f(p1[r] - mrow); s += p0[r] + p1[r]; }
    lrow += s;
    bf16x8 pa[4];
    { u32x4 w;
      w.x = cvtpk(p0[0], p0[1]); w.y = cvtpk(p0[2], p0[3]); w.z = cvtpk(p0[4], p0[5]); w.w = cvtpk(p0[6], p0[7]); pa[0] = __builtin_bit_cast(bf16x8, w);
      w.x = cvtpk(p0[8], p0[9]); w.y = cvtpk(p0[10], p0[11]); w.z = cvtpk(p0[12], p0[13]); w.w = cvtpk(p0[14], p0[15]); pa[1] = __builtin_bit_cast(bf16x8, w);
      w.x = cvtpk(p1[0], p1[1]); w.y = cvtpk(p1[2], p1[3]); w.z = cvtpk(p1[4], p1[5]); w.w = cvtpk(p1[6], p1[7]); pa[2] = __builtin_bit_cast(bf16x8, w);
      w.x = cvtpk(p1[8], p1[9]); w.y = cvtpk(p1[10], p1[11]); w.z = cvtpk(p1[12], p1[13]); w.w = cvtpk(p1[14], p1[15]); pa[3] = __builtin_bit_cast(bf16x8, w); }
#pragma unroll
    for (int d = 0; d < 4; ++d)
#pragma unroll
        for (int ks = 0; ks < 4; ++ks) {
            const s16x4 lo = vtr(vp + d * 4096 + ks * 1024), hh = vtr(vp + d * 4096 + ks * 1024 + 512);
            const bf16x8 vf = (bf16x8){lo[0], lo[1], lo[2], lo[3], hh[0], hh[1], hh[2], hh[3]};
            o[d] = MFMA32(pa[ks], vf, o[d]);
        }
}

constexpr int DA_KOFF = 0, DA_VOFF = 49152, DA_QOFF = 98304, DA_BUF = 16384, DA_XLD = 132;
#define DA_THR 8.0f
#define FMAX3(a, b, c) __builtin_fmaxf(__builtin_fmaxf((a), (b)), (c))
__device__ __forceinline__ float rowmax32(const f32x16& a, const f32x16& b) {
    float m0 = FMAX3(a[0], a[1], b[0]), m1 = FMAX3(a[2], a[3], b[1]); m0 = FMAX3(m0, b[2], b[3]);
#pragma unroll
    for (int r = 4; r < 16; r += 4) { m0 = FMAX3(m0, a[r], a[r + 1]); m1 = FMAX3(m1, a[r + 2], a[r + 3]); m0 = FMAX3(m0, b[r], b[r + 1]); m1 = FMAX3(m1, b[r + 2], b[r + 3]); }
    float m = __builtin_fmaxf(m0, m1);
    auto rr = __builtin_amdgcn_permlane32_swap(__float_as_uint(m), __float_as_uint(m), false, false);
    return __builtin_fmaxf(__uint_as_float(rr[0]), __uint_as_float(rr[1]));
}
__device__ __forceinline__ void da_unit(const int tid_in, int b, int h, int qb, const bf16_t* Q, const bf16_t* Kg, const bf16_t* Vg, bf16_t* O, int ldo, float lam, const float* gsub, LAS unsigned char* lds) {
    int tid = tid_in; asm volatile("" : "+v"(tid));
    const int lane = tid & 63, r32 = lane & 31, hi = lane >> 5; const int wid = __builtin_amdgcn_readfirstlane(tid >> 6);
    const int comp = wid >> 2, w4 = wid & 3;
    const size_t rowbase = (size_t)b * SEQ;
    LAS float* wsf = (LAS float*)(lds + WSF_OFF) + wid * 64;
    const LAS char* qfrag = (const LAS char*)lds + DA_QOFF + wid * 4096 + lane * 16;
    { const bf16_t* Qw = Q + (rowbase + qb * 128 + w4 * 32 + r32) * DM + h * 128 + comp * 64 + hi * 8;
#pragma unroll
      for (int d0 = 0; d0 < 4; ++d0) *(LAS bf16x8*)(lds + DA_QOFF + wid * 4096 + d0 * 1024 + lane * 16) = *(const bf16x8*)(Qw + d0 * 16); }
#define qr_(d0) (*(const LAS bf16x8*)(qfrag + (d0) * 1024))
    const int NT = 2 * qb + 2;
    unsigned ksrc[2], vsrc[2], kdst[2], vdst[2];
#pragma unroll
    for (int j = 0; j < 2; ++j) { const int p = wid * 2 + j;
        ksrc[j] = (unsigned)(((rowbase + 16 * ((p >> 1) & 3) + (lane >> 2)) * DM + h * 128 + (p >> 3) * 64 + (p & 1) * 32 + (((lane & 3) ^ ((lane >> 4) & 3)) * 8)) * 2); kdst[j] = DA_KOFF + p * 1024;
        vsrc[j] = (unsigned)(((rowbase + 16 * (p & 3) + (lane >> 2)) * DM + h * 128 + (p >> 2) * 32 + (lane & 3) * 8) * 2); vdst[j] = DA_VOFF + p * 1024; }
#define DA_DMA_K(t, soff) do { _Pragma("unroll") for (int j_ = 0; j_ < 2; ++j_) \
        __builtin_amdgcn_global_load_lds((const unsigned*)((const char*)Kg + (size_t)(ksrc[j_] + (unsigned)(t) * (64u * DM * 2u))), (LAS unsigned*)(lds + kdst[j_] + (soff)), 16, 0, 0); } while (0)
#define DA_DMA_V(t, soff) do { _Pragma("unroll") for (int j_ = 0; j_ < 2; ++j_) \
        __builtin_amdgcn_global_load_lds((const unsigned*)((const char*)Vg + (size_t)(vsrc[j_] + (unsigned)(t) * (64u * DM * 2u))), (LAS unsigned*)(lds + vdst[j_] + (soff)), 16, 0, 0); } while (0)
    float mref = 0.f, lrow = 0.f; f32x16 o[4], negm;
#pragma unroll
    for (int r = 0; r < 16; ++r) { negm[r] = 0.f;
#pragma unroll
        for (int d = 0; d < 4; ++d) o[d][r] = 0.f; }
    const LAS char* ldc = (const LAS char*)lds;
    const LAS char* kbase = ldc + DA_KOFF + comp * 8192 + (r32 >> 4) * 2048 + (r32 & 15) * 64;
    const int kswz = (hi ^ ((r32 >> 2) & 3)) * 16;
    const LAS char* vbase = ldc + DA_VOFF + ((lane >> 4) & 1) * 32 + (lane & 3) * 8 + (4 * hi + ((lane & 15) >> 2)) * 64;
    const int qpos = qb * 128 + w4 * 32 + r32;
#define DA_KF(d0, half) (*(const LAS bf16x8*)(kb_ + ((d0) >> 1) * 1024 + (((d0) & 1) ? (kswz ^ 32) : kswz) + (half) * 4096))
#define DA_QK(P0, P1, soff) do { const LAS char* kb_ = kbase + (soff); \
        { const bf16x8 b0_ = DA_KF(0, 0), b1_ = DA_KF(0, 1); P0 = MFMA32(b0_, qr_(0), negm); P1 = MFMA32(b1_, qr_(0), negm); } \
        _Pragma("unroll") for (int d0_ = 1; d0_ < 4; ++d0_) { const bf16x8 b0_ = DA_KF(d0_, 0), b1_ = DA_KF(d0_, 1); \
            P0 = MFMA32(b0_, qr_(d0_), P0); P1 = MFMA32(b1_, qr_(d0_), P1); } } while (0)
#define DA_MASK(P0, P1, t) do { const int kb_ = 64 * (t) + 4 * hi; \
        _Pragma("unroll") for (int r = 0; r < 16; ++r) { const int kv_ = kb_ + (r & 3) + 8 * (r >> 2); if (kv_ > qpos) P0[r] = -__builtin_inff(); if (kv_ + 32 > qpos) P1[r] = -__builtin_inff(); } } while (0)
#define DA_MOVE_REF(P0, P1, dl) do { mref += (dl); \
        _Pragma("unroll") for (int r = 0; r < 16; ++r) { P0[r] -= (dl); P1[r] -= (dl); negm[r] = -mref; } \
        const float f_ = __builtin_amdgcn_exp2f(-(dl)); lrow *= f_; if (hi == 0) wsf[r32] = f_; LDS_WAIT(); \
        _Pragma("unroll") for (int g = 0; g < 4; ++g) { const f32x4 f4 = *(const LAS f32x4*)(wsf + 8 * g + 4 * hi); \
            _Pragma("unroll") for (int d = 0; d < 4; ++d) { o[d][4 * g + 0] *= f4[0]; o[d][4 * g + 1] *= f4[1]; o[d][4 * g + 2] *= f4[2]; o[d][4 * g + 3] *= f4[3]; } } } while (0)
#define DA_STEP(PC0, PC1, PN0, PN1, tt) do { const int t_ = (tt); \
        if (t_ + 3 < NT) DA_DMA_K(t_ + 3, sKf); \
        if (t_ + 2 < NT) DA_DMA_V(t_ + 2, sVf); \
        const bool actn_ = (t_ + 1 < NT) && !((t_ + 1 == NT - 1) && w4 < 2), actc_ = !((t_ == NT - 1) && w4 < 2); \
        if (actn_) { DA_QK(PN0, PN1, sKc); if (t_ + 1 >= NT - 2) DA_MASK(PN0, PN1, t_ + 1); } \
        if (actc_) { float s_ = 0.f; \
            _Pragma("unroll") for (int r = 0; r < 16; ++r) { PC0[r] = __builtin_amdgcn_exp2f(PC0[r]); PC1[r] = __builtin_amdgcn_exp2f(PC1[r]); s_ += PC0[r]; s_ += PC1[r]; } \
            lrow += s_; \
            bf16x8 pa_[4]; { u32x4 w_; \
              w_.x = cvtpk(PC0[0], PC0[1]); w_.y = cvtpk(PC0[2], PC0[3]); w_.z = cvtpk(PC0[4], PC0[5]); w_.w = cvtpk(PC0[6], PC0[7]); pa_[0] = __builtin_bit_cast(bf16x8, w_); \
              w_.x = cvtpk(PC0[8], PC0[9]); w_.y = cvtpk(PC0[10], PC0[11]); w_.z = cvtpk(PC0[12], PC0[13]); w_.w = cvtpk(PC0[14], PC0[15]); pa_[1] = __builtin_bit_cast(bf16x8, w_); \
              w_.x = cvtpk(PC1[0], PC1[1]); w_.y = cvtpk(PC1[2], PC1[3]); w_.z = cvtpk(PC1[4], PC1[5]); w_.w = cvtpk(PC1[6], PC1[7]); pa_[2] = __builtin_bit_cast(bf16x8, w_); \
              w_.x = cvtpk(PC1[8], PC1[9]); w_.y = cvtpk(PC1[10], PC1[11]); w_.z = cvtpk(PC1[12], PC1[13]); w_.w = cvtpk(PC1[14], PC1[15]); pa_[3] = __builtin_bit_cast(bf16x8, w_); } \
            const LAS char* vp_ = vbase + sVc; \
            _Pragma("unroll") for (int d = 0; d < 4; ++d) _Pragma("unroll") for (int ks = 0; ks < 4; ++ks) { \
                const s16x4 lo_ = vtr(vp_ + d * 4096 + ks * 1024), hh_ = vtr(vp_ + d * 4096 + ks * 1024 + 512); \
                const bf16x8 vf_ = (bf16x8){lo_[0], lo_[1], lo_[2], lo_[3], hh_[0], hh_[1], hh_[2], hh_[3]}; \
                o[d] = MFMA32(pa_[ks], vf_, o[d]); } } \
        if (actn_) { const float rm_ = rowmax32(PN0, PN1); \
            if (__any(rm_ > DA_THR)) { const float dl_ = __builtin_fmaxf(rm_, 0.f); DA_MOVE_REF(PN0, PN1, dl_); } } \
        { const unsigned x_ = sKf; sKf = sKc; sKc = sKn; sKn = x_; const unsigned y_ = sVf; sVf = sVc; sVc = sVn; sVn = y_; } \
        WG_BAR(); } while (0)

#define DA_PIN(x) asm volatile("" : "+v"(x))
#define DA_GAP() __builtin_amdgcn_sched_barrier(0)
#define DA_VF(i) ({ const s16x4 lo_ = vtr(vp_ + ((i) & 3) * 4096 + ((i) >> 2) * 1024), hh_ = vtr(vp_ + ((i) & 3) * 4096 + ((i) >> 2) * 1024 + 512); (bf16x8){lo_[0], lo_[1], lo_[2], lo_[3], hh_[0], hh_[1], hh_[2], hh_[3]}; })
#define DA_EXP8(P, B) do { _Pragma("unroll") for (int r_ = 0; r_ < 8; ++r_) P[(B) + r_] = __builtin_amdgcn_exp2f(P[(B) + r_]); DA_PIN(P); } while (0)
#define DA_PVGAP(i, PA, PKSTMT) do { o[(i) & 3] = MFMA32(PA, vf_[(i) % 3], o[(i) & 3]); if ((i) + 3 < 16) vf_[(i) % 3] = DA_VF((i) + 3); \
        sA_ += PCa[i]; sB_ += PCb[i]; DA_PIN(sA_); DA_PIN(sB_); PKSTMT; mx_ = FMAX3(mx_, PNa[i], PNb[i]); DA_PIN(mx_); DA_GAP(); } while (0)
#define DA_STEPX(PC0, PC1, PN0, PN1, tt) do { const int t_ = (tt); \
        if (t_ + 3 < NT) DA_DMA_K(t_ + 3, sKf); DA_DMA_V(t_ + 2, sVf); \
        const LAS char* kb_ = kbase + sKc; const LAS char* vp_ = vbase + sVc; bf16x8 vf_[3]; \
        PN0 = MFMA32(ka_, qa_, negm); PN1 = MFMA32(kb2_, qa_, negm); ka_ = DA_KF(2, 0); kb2_ = DA_KF(2, 1); qa_ = qr_(1); DA_EXP8(PC0, 0); DA_GAP(); \
        PN0 = MFMA32(kc_, qa_, PN0); PN1 = MFMA32(kd_, qa_, PN1); kc_ = DA_KF(3, 0); kd_ = DA_KF(3, 1); qa_ = qr_(2); DA_EXP8(PC0, 8); DA_GAP(); \
        PN0 = MFMA32(ka_, qa_, PN0); PN1 = MFMA32(kb2_, qa_, PN1); qa_ = qr_(3); vf_[0] = DA_VF(0); DA_EXP8(PC1, 0); DA_GAP(); \
        PN0 = MFMA32(kc_, qa_, PN0); PN1 = MFMA32(kd_, qa_, PN1); vf_[1] = DA_VF(1); vf_[2] = DA_VF(2); DA_EXP8(PC1, 8); DA_GAP(); \
        if (t_ + 1 >= NT - 2) DA_MASK(PN0, PN1, t_ + 1); \
        u32x4 we_, wo_; float sA_ = 0.f, sB_ = 0.f, mx_ = -__builtin_inff(); \
        we_.x = cvtpk(PC0[0], PC0[1]); we_.y = cvtpk(PC0[2], PC0[3]); we_.z = cvtpk(PC0[4], PC0[5]); we_.w = cvtpk(PC0[6], PC0[7]); DA_GAP(); \
        { const f32x16& PCa = PC0; const f32x16& PCb = PC1; const f32x16& PNa = PN0; const f32x16& PNb = PN1; \
        DA_PVGAP(0, __builtin_bit_cast(bf16x8, we_), wo_.x = cvtpk(PC0[8], PC0[9]));   DA_PVGAP(1, __builtin_bit_cast(bf16x8, we_), wo_.y = cvtpk(PC0[10], PC0[11])); \
        DA_PVGAP(2, __builtin_bit_cast(bf16x8, we_), wo_.z = cvtpk(PC0[12], PC0[13])); DA_PVGAP(3, __builtin_bit_cast(bf16x8, we_), wo_.w = cvtpk(PC0[14], PC0[15])); \
        DA_PVGAP(4, __builtin_bit_cast(bf16x8, wo_), we_.x = cvtpk(PC1[0], PC1[1]));   DA_PVGAP(5, __builtin_bit_cast(bf16x8, wo_), we_.y = cvtpk(PC1[2], PC1[3])); \
        DA_PVGAP(6, __builtin_bit_cast(bf16x8, wo_), we_.z = cvtpk(PC1[4], PC1[5]));   DA_PVGAP(7, __builtin_bit_cast(bf16x8, wo_), we_.w = cvtpk(PC1[6], PC1[7])); \
        DA_PVGAP(8, __builtin_bit_cast(bf16x8, we_), wo_.x = cvtpk(PC1[8], PC1[9]));   DA_PVGAP(9, __builtin_bit_cast(bf16x8, we_), wo_.y = cvtpk(PC1[10], PC1[11])); \
        DA_PVGAP(10, __builtin_bit_cast(bf16x8, we_), wo_.z = cvtpk(PC1[12], PC1[13])); DA_PVGAP(11, __builtin_bit_cast(bf16x8, we_), wo_.w = cvtpk(PC1[14], PC1[15])); \
        DA_PVGAP(12, __builtin_bit_cast(bf16x8, wo_), (void)0); DA_PVGAP(13, __builtin_bit_cast(bf16x8, wo_), (void)0); DA_PVGAP(14, __builtin_bit_cast(bf16x8, wo_), (void)0); DA_PVGAP(15, __builtin_bit_cast(bf16x8, wo_), (void)0); } \
        lrow += sA_ + sB_; \
        { kb_ = kbase + sKn; ka_ = DA_KF(0, 0); kb2_ = DA_KF(0, 1); kc_ = DA_KF(1, 0); kd_ = DA_KF(1, 1); qa_ = qr_(0); }                        \
        { auto rr_ = __builtin_amdgcn_permlane32_swap(__float_as_uint(mx_), __float_as_uint(mx_), false, false); mx_ = __builtin_fmaxf(__uint_as_float(rr_[0]), __uint_as_float(rr_[1])); } \
        if (__any(mx_ > DA_THR)) { const float dl_ = __builtin_fmaxf(mx_, 0.f); DA_MOVE_REF(PN0, PN1, dl_); } \
        { const unsigned x_ = sKf; sKf = sKc; sKc = sKn; sKn = x_; const unsigned y_ = sVf; sVf = sVc; sVc = sVn; sVn = y_; } \
        if (t_ + 3 < NT) asm volatile("s_waitcnt vmcnt(4) lgkmcnt(0)\n\ts_barrier" ::: "memory");            \
        else asm volatile("s_waitcnt vmcnt(2) lgkmcnt(0)\n\ts_barrier" ::: "memory"); } while (0)

    f32x16 pA0, pA1, pB0, pB1;
#define DA_START() do { DA_DMA_K(0, 0); DA_DMA_V(0, 0); DA_DMA_K(1, DA_BUF); DA_DMA_V(1, DA_BUF); if (NT > 2) DA_DMA_K(2, 2 * DA_BUF); \
    WG_BAR(); \
    DA_QK(pA0, pA1, 0); \
    if (NT == 2) DA_MASK(pA0, pA1, 0); \
    { const float rm = rowmax32(pA0, pA1); mref = rm;                          \
      _Pragma("unroll") for (int r = 0; r < 16; ++r) { pA0[r] -= rm; pA1[r] -= rm; negm[r] = -mref; } } \
    WG_BAR(); } while (0)
    unsigned sKc = DA_BUF, sKn = 2 * DA_BUF, sKf = 0;
    unsigned sVc = 0, sVn = DA_BUF, sVf = 2 * DA_BUF;
    if (NT == 2) {
        DA_START();
        DA_STEP(pA0, pA1, pB0, pB1, 0);
        DA_STEP(pB0, pB1, pA0, pA1, 1);
    } else {
        DA_START();
        bf16x8 ka_, kb2_, kc_, kd_, qa_;
        { const LAS char* kb_ = kbase + sKc; ka_ = DA_KF(0, 0); kb2_ = DA_KF(0, 1); kc_ = DA_KF(1, 0); kd_ = DA_KF(1, 1); qa_ = qr_(0); }
        int t = 0;
        do {
            DA_STEPX(pA0, pA1, pB0, pB1, t);
            DA_STEPX(pB0, pB1, pA0, pA1, t + 1);
            t += 2;
        } while (t + 2 < NT);
        DA_STEP(pA0, pA1, pB0, pB1, t);
        DA_STEP(pB0, pB1, pA0, pA1, t + 1);
    }
#undef DA_START
#undef DA_DMA_K
#undef DA_DMA_V
#undef DA_QK
#undef DA_MASK
#undef DA_MOVE_REF
#undef DA_STEP
#undef qr_
#undef DA_STEPX
#undef DA_PVGAP
#undef DA_EXP8
#undef DA_VF
#undef DA_KF
#undef DA_GAP
#undef DA_PIN
    int le_ = lane; asm volatile("" : "+v"(le_)); const int r32e = le_ & 31, hie = le_ >> 5;
    { auto rr = __builtin_amdgcn_permlane32_swap(__float_as_uint(lrow), __float_as_uint(lrow), false, false); lrow = __uint_as_float(rr[0]) + __uint_as_float(rr[1]); }
    if (hie == 0) wsf[32 + r32e] = lrow;
    LDS_WAIT();
    float inv[16];
#pragma unroll
    for (int g = 0; g < 4; ++g) { const f32x4 l4 = *(const LAS f32x4*)(wsf + 32 + 8 * g + 4 * hie);
#pragma unroll
        for (int e = 0; e < 4; ++e) inv[4 * g + e] = __builtin_amdgcn_rcpf(l4[e]); }
    LAS float* X = (LAS float*)lds;
    if (comp == 1) {
#pragma unroll
        for (int d = 0; d < 4; ++d)
#pragma unroll
            for (int r = 0; r < 16; ++r) X[(w4 * 32 + crow(r, hie)) * DA_XLD + d * 32 + r32e] = lam * o[d][r] * inv[r];
    }
    WG_BAR();
    if (comp == 0) {
#pragma unroll
        for (int d = 0; d < 4; ++d)
#pragma unroll
            for (int r = 0; r < 16; ++r) { LAS float* xp = X + (w4 * 32 + crow(r, hie)) * DA_XLD + d * 32 + r32e; *xp = o[d][r] * inv[r] - *xp; }
    }
    WG_BAR();
    { const f32x2 g2 = *(const f32x2*)(gsub + 2 * le_);
#pragma unroll 4
      for (int i = 0; i < 16; ++i) { const int row = wid * 16 + i;
          const f32x2 v = *(const LAS f32x2*)(X + row * DA_XLD + 2 * le_);
          const float ss = wave_sum(v.x * v.x + v.y * v.y);
          const float rs = __builtin_amdgcn_rsqf(ss * (1.0f / 128.0f) + EPS) * (1.0f - LAMBDA_INIT);
          *(unsigned*)(O + (rowbase + qb * 128 + row) * ldo + h * 128 + 2 * le_) = cvtpk(v.x * rs * g2.x, v.y * rs * g2.y); } }
    WG_BAR();
}

constexpr int CA_KOFF = 0, CA_VOFF = 65536;
__device__ __forceinline__ void ca_unit(const int tid, int b, int hm, int qc, const bf16_t* QM, const bf16_t* KM, const bf16_t* VM, bf16_t* OM, int ldo, LAS unsigned char* lds) {
    const int lane = tid & 63, r32 = lane & 31, hi = lane >> 5; const int wid = __builtin_amdgcn_readfirstlane(tid >> 6);
    LAS float* wsf = (LAS float*)(lds + WSF_OFF) + wid * 64;
#pragma unroll
    for (int j = 0; j < 16; ++j) { const int P = wid * 16 + j;
        if (P < 64) { const int kt = P >> 4, ch = P & 15;
            __builtin_amdgcn_global_load_lds((const unsigned*)(KM + (size_t)(b * MEMLEN + 64 * kt + lane) * 512 + hm * 128 + ch * 8), (LAS unsigned*)(lds + CA_KOFF + kt * 16384 + ch * 1024), 16, 0, 0);
        } else { const int P2 = P - 64, kt = P2 >> 4, pv = P2 & 15;
            __builtin_amdgcn_global_load_lds((const unsigned*)(VM + (size_t)(b * MEMLEN + 64 * kt + 16 * (pv & 3) + (lane >> 2)) * 512 + hm * 128 + (pv >> 2) * 32 + (lane & 3) * 8), (LAS unsigned*)(lds + CA_VOFF + kt * 16384 + pv * 1024), 16, 0, 0); } }
    WG_BAR();
    const LAS char* ldc = (const LAS char*)lds;
    const int vlane = ((lane >> 4) & 1) * 32 + (lane & 3) * 8 + (4 * hi + ((lane & 15) >> 2)) * 64;
#pragma unroll 1
    for (int pass = 0; pass < 4; ++pass) {
        const size_t row0 = (size_t)b * SEQ + qc * 1024 + pass * 256 + wid * 32;
        bf16x8 qr[8]; float ssq = 0.f;
        { const bf16_t* Qw = QM + (row0 + r32) * 512 + hm * 128 + hi * 8;
#pragma unroll
          for (int d0 = 0; d0 < 8; ++d0) { qr[d0] = *(const bf16x8*)(Qw + d0 * 16); const u32x4 w = __builtin_bit_cast(u32x4, qr[d0]);
              float a;
              a = bf_lo(w.x); ssq += a * a; a = bf_hi(w.x); ssq += a * a; a = bf_lo(w.y); ssq += a * a; a = bf_hi(w.y); ssq += a * a;
              a = bf_lo(w.z); ssq += a * a; a = bf_hi(w.z); ssq += a * a; a = bf_lo(w.w); ssq += a * a; a = bf_hi(w.w); ssq += a * a; } }
        { auto rr = __builtin_amdgcn_permlane32_swap(__float_as_uint(ssq), __float_as_uint(ssq), false, false); ssq = __uint_as_float(rr[0]) + __uint_as_float(rr[1]); }
        const float rq = __builtin_amdgcn_rsqf(ssq * (1.0f / 128.0f) + EPS);
        float mrow = -__builtin_inff(), lrow = 0.f; f32x16 o[4];
#pragma unroll
        for (int d = 0; d < 4; ++d)
#pragma unroll
            for (int r = 0; r < 16; ++r) o[d][r] = 0.f;
#pragma unroll 1
        for (int kt = 0; kt < 4; ++kt) {
            f32x16 p0, p1;
            qk_tile<8>(p0, p1, ldc + CA_KOFF + kt * 16384 + hi * 1024 + r32 * 16, qr);
#pragma unroll
            for (int r = 0; r < 16; ++r) { p0[r] *= rq; p1[r] *= rq; }
            softmax_pv(p0, p1, mrow, lrow, o, ldc + CA_VOFF + kt * 16384 + vlane, wsf, r32, hi);
        }
        { auto rr = __builtin_amdgcn_permlane32_swap(__float_as_uint(lrow), __float_as_uint(lrow), false, false); lrow = __uint_as_float(rr[0]) + __uint_as_float(rr[1]); }
        if (hi == 0) wsf[32 + r32] = lrow;
        LDS_WAIT();
#pragma unroll
        for (int g = 0; g < 4; ++g) { const f32x4 l4 = *(const LAS f32x4*)(wsf + 32 + 8 * g + 4 * hi);
#pragma unroll
            for (int e = 0; e < 4; ++e) { const float iv = __builtin_amdgcn_rcpf(l4[e]); const int r = 4 * g + e;
                bf16_t* op = OM + (row0 + crow(r, hi)) * ldo + hm * 128 + r32;
#pragma unroll
                for (int d = 0; d < 4; ++d) op[d * 32] = (bf16_t)(cvtpk(o[d][r] * iv, 0.f) & 0xffffu); } }
        LDS_WAIT();
    }
    WG_BAR();
}
#undef MFMA32
}
#define XB_TMO      128
#define XB_XCNT(j)  (256  + 64 * (j))
#define XB_XSUB(j)  (1280 + 64 * (j))
#define XB_XGEN(j)  (2304 + 64 * (j))
#define XB_TOP      3328
#define XB_TOPGEN   3392
#define XCD_BAR_WORDS 3456
#define XB_SPIN_CAP (1u << 18)

__device__ __forceinline__ unsigned xb_ld(unsigned* p)              { return __hip_atomic_load(p, __ATOMIC_RELAXED, __HIP_MEMORY_SCOPE_AGENT); }
__device__ __forceinline__ unsigned xb_add(unsigned* p, unsigned v) { return __hip_atomic_fetch_add(p, v, __ATOMIC_RELAXED, __HIP_MEMORY_SCOPE_AGENT); }
__device__ __forceinline__ unsigned xb_xcc_id() { return (unsigned)__builtin_amdgcn_s_getreg((3 << 11) | 20) & 0xFu; }
#define XB_SPIN(cond, bar) do { unsigned _sp = 0; while (cond) { __builtin_amdgcn_s_sleep(1); \
    if ((++_sp & 255u) == 0u) { if (xb_ld(&(bar)[XB_TMO])) break; if (_sp > XB_SPIN_CAP) { atomicAdd(&(bar)[XB_TMO], 1u); break; } } } } while (0)

struct XcdBarrier { unsigned* bar; unsigned x; volatile LAS unsigned* st; };

__device__ __forceinline__ XcdBarrier xcd_barrier_post(unsigned* bar, volatile LAS unsigned* st) {
    XcdBarrier b; b.bar = bar; b.x = xb_xcc_id(); b.st = st;
    if (threadIdx.x == 0) (void)xb_add(&bar[XB_XCNT(b.x)], 1u);
    return b;
}
__device__ __forceinline__ void xcd_barrier_complete(unsigned* bar, unsigned x, unsigned& nloc, unsigned& nx) {
    const unsigned G = gridDim.x * gridDim.y * gridDim.z;
    unsigned sum, cnt, mine, sp = 0u;
    for (;;) {
        sum = 0u; cnt = 0u; mine = 0u;
#pragma unroll 1
        for (unsigned j = 0; j < 16; ++j) { const unsigned c = xb_ld(&bar[XB_XCNT(j)]); sum += c; cnt += (c > 0u) ? 1u : 0u; mine = (j == x) ? c : mine; }
        if (sum == G) break;
        __builtin_amdgcn_s_sleep(1);
        if ((++sp & 255u) == 0u) { if (xb_ld(&bar[XB_TMO])) break; if (sp > XB_SPIN_CAP) { atomicAdd(&bar[XB_TMO], 1u); break; } }
    }
    nloc = mine > 0u ? mine : 1u; nx = cnt > 0u ? cnt : 1u;
}
__device__ __forceinline__ void xcd_barrier(const XcdBarrier& b) {
    asm volatile("s_waitcnt vmcnt(0)" ::: "memory");
    __syncthreads();
    if (threadIdx.x == 0) {
        unsigned* bar = b.bar;
        __builtin_amdgcn_s_waitcnt(0);
        unsigned nloc = b.st[0], nx = b.st[1];
        if (nloc == 0u) { xcd_barrier_complete(bar, b.x, nloc, nx); b.st[0] = nloc; b.st[1] = nx; }
        const unsigned old = xb_add(&bar[XB_XSUB(b.x)], 1u);
        const unsigned gen = old / nloc;
        if (old + 1u == (gen + 1u) * nloc) {
            __builtin_amdgcn_fence(__ATOMIC_RELEASE, "agent");
            asm volatile("s_waitcnt vmcnt(0)" ::: "memory");
            const unsigned og = xb_add(&bar[XB_TOP], 1u);
            const unsigned tg = og / nx;
            if (og + 1u == (tg + 1u) * nx) xb_add(&bar[XB_TOPGEN], 1u);
            else XB_SPIN(xb_ld(&bar[XB_TOPGEN]) == tg, bar);
            __builtin_amdgcn_fence(__ATOMIC_ACQUIRE, "agent");
            xb_add(&bar[XB_XGEN(b.x)], 1u);
            asm volatile("s_waitcnt vmcnt(0)" ::: "memory");
        } else {
            XB_SPIN(xb_ld(&bar[XB_XGEN(b.x)]) == gen, bar);
            __builtin_amdgcn_fence(__ATOMIC_ACQUIRE, "agent");
            asm volatile("s_waitcnt vmcnt(0)" ::: "memory");
        }
    }
    __syncthreads();
}

typedef __attribute__((address_space(4))) const unsigned char* kptr_t;
__device__ __forceinline__ kptr_t karg_base() { kptr_t kp = (kptr_t)__builtin_amdgcn_kernarg_segment_ptr(); asm volatile("" : "+s"(kp)); return kp; }
typedef const float* cfptr_t; typedef float* fptr_t; typedef unsigned char* ucptr_t;
struct InTab { __device__ __forceinline__ const float* operator[](int i) const { return *(const __attribute__((address_space(4))) cfptr_t*)(karg_base() + 8 * i); } };
struct Frame {
    LAS unsigned char* lds; volatile LAS unsigned* MISC; unsigned* ctl;
    int tid, lane, wave, vcu, G;
    InTab in; float* out; unsigned char* ws;
};
#define MKFRAME(F) Frame F; { int w_ = wave_s; asm volatile("" : "+s"(w_)); int t_; asm volatile("v_mbcnt_lo_u32_b32 %0, -1, 0\n\tv_mbcnt_hi_u32_b32 %0, -1, %0" : "=v"(t_)); F.lane = t_; F.wave = w_; F.tid = w_ * 64 + t_; \
    F.lds = (LAS unsigned char*)lds_raw; F.MISC = (volatile LAS unsigned*)(F.lds + MISC_OFF); F.G = gridDim.x; { const int bx_ = blockIdx.x; F.vcu = (F.G % 8 == 0) ? (bx_ % 8) * (F.G / 8) + bx_ / 8 : bx_; } \
    F.out = *(const __attribute__((address_space(4))) fptr_t*)(karg_base() + 31 * 8); F.ws = *(const __attribute__((address_space(4))) ucptr_t*)(karg_base() + 32 * 8); F.ctl = (unsigned*)(F.ws + WS_CTL); }
enum { I_X = 0, I_MEM, I_GMIX, I_WIN, I_BG, I_QN, I_KN, I_LQ1, I_LK1, I_LQ2, I_LK2, I_GSUB, I_PW, I_PS, I_GMEM, I_WKV, I_MQ, I_MK, I_WBA, I_WBP, I_WBM, I_WOUT, I_GFFN, I_WR, I_BR,
       I_WG, I_BGATE, I_WU, I_BUP, I_WD, I_BDOWN };
constexpr int MI_CNT = 16, MI_CUM = 48, MI_LC = 96, MI_LB = 128, MI_RB = 256;

template <int MAP> __device__ __forceinline__ int rowmap(int n) {
    if (MAP == 1) { if (n >= 2048) return n; const int nl = n & 255; return (n & ~255) + 128 * ((nl >> 5) & 1) + 32 * (nl >> 6) + (nl & 31); }
    if (MAP == 2) return 256 * (n >> 7) + (n & 127);
    if (MAP == 3) return 256 * (n >> 7) + 128 + (n & 127);
    return n;
}
template <int MAP> __device__ __forceinline__ void transpose_item(const float* W, int K, int N, int ld, bf16_t* WT, const float* kscale, LAS float* scr, int item, int lane, int ldk = 0) {
    if (ldk == 0) ldk = K;
    const int nblk = N / 32, kb = item / nblk, nb = item % nblk, k0 = 64 * kb, n0 = 32 * nb;
#pragma unroll
    for (int i = 0; i < 8; ++i) { const int kk = 8 * i + (lane >> 3), nn = (lane & 7) * 4;
        f32x4 v = *(const f32x4*)(W + (size_t)(k0 + kk) * ld + n0 + nn);
        if (kscale) v = v * kscale[k0 + kk];
        LAS float* s = scr + kk * 33 + nn; s[0] = v[0]; s[1] = v[1]; s[2] = v[2]; s[3] = v[3]; }
    LDS_WAIT(); asm volatile("" ::: "memory");
    const int c = lane & 7;
#pragma unroll
    for (int j = 0; j < 4; ++j) { const int n = (lane >> 3) + 8 * j; const LAS float* s = scr + (8 * c) * 33 + n;
        u32x4 o; o.x = cvtpk(s[0 * 33], s[1 * 33]); o.y = cvtpk(s[2 * 33], s[3 * 33]); o.z = cvtpk(s[4 * 33], s[5 * 33]); o.w = cvtpk(s[6 * 33], s[7 * 33]);
        *(u32x4*)(WT + (size_t)rowmap<MAP>(n0 + n) * ldk + k0 + 8 * c) = o; }
    LDS_WAIT(); asm volatile("" ::: "memory");
}
__device__ __forceinline__ void rms_row_to_bf16(const float* xrow, const float* gain, bf16_t* orow, int lane) {
    const f32x4* xr = (const f32x4*)xrow + lane; const f32x4* gr = (const f32x4*)gain + lane;
    f32x4 v[4]; float s = 0.f;
#pragma unroll
    for (int j = 0; j < 4; ++j) { v[j] = xr[64 * j]; s += (v[j].x * v[j].x + v[j].y * v[j].y) + (v[j].z * v[j].z + v[j].w * v[j].w); }
    const float rstd = __builtin_amdgcn_rsqf(wave_sum(s) * (1.f / DM) + EPS);
    u32x2* o8 = (u32x2*)orow + lane;
#pragma unroll
    for (int j = 0; j < 4; ++j) { const f32x4 g = gr[64 * j]; u32x2 w; w.x = cvtpk(v[j].x * rstd * g.x, v[j].y * rstd * g.y); w.y = cvtpk(v[j].z * rstd * g.z, v[j].w * rstd * g.w); o8[64 * j] = w; }
}

template <int MAP> __device__ __forceinline__ void transpose_item8(const float* W, int K, int N, int ld, unsigned char* WT, const float* kscale, LAS float* scr, int item, int lane) {
    const int nblk = N / 32, kb = item / nblk, nb = item % nblk, k0 = 64 * kb, n0 = 32 * nb;
#pragma unroll
    for (int i = 0; i < 8; ++i) { const int kk = 8 * i + (lane >> 3), nn = (lane & 7) * 4;
        f32x4 v = *(const f32x4*)(W + (size_t)(k0 + kk) * ld + n0 + nn);
        v = v * (kscale ? kscale[k0 + kk] * W8_SCALE : W8_SCALE);
        LAS float* s = scr + kk * 33 + nn; s[0] = v[0]; s[1] = v[1]; s[2] = v[2]; s[3] = v[3]; }
    LDS_WAIT(); asm volatile("" ::: "memory");
    { const int n = lane >> 1, kh = lane & 1; const LAS float* s = scr + (32 * kh) * 33 + n;
      u32x4 o0, o1;
      o0.x = cvt4_fp8(s[0 * 33], s[1 * 33], s[2 * 33], s[3 * 33]);     o0.y = cvt4_fp8(s[4 * 33], s[5 * 33], s[6 * 33], s[7 * 33]);
      o0.z = cvt4_fp8(s[8 * 33], s[9 * 33], s[10 * 33], s[11 * 33]);   o0.w = cvt4_fp8(s[12 * 33], s[13 * 33], s[14 * 33], s[15 * 33]);
      o1.x = cvt4_fp8(s[16 * 33], s[17 * 33], s[18 * 33], s[19 * 33]); o1.y = cvt4_fp8(s[20 * 33], s[21 * 33], s[22 * 33], s[23 * 33]);
      o1.z = cvt4_fp8(s[24 * 33], s[25 * 33], s[26 * 33], s[27 * 33]); o1.w = cvt4_fp8(s[28 * 33], s[29 * 33], s[30 * 33], s[31 * 33]);
      unsigned char* op = WT + (size_t)rowmap<MAP>(n0 + n) * K + k0 + 32 * kh;
      *(u32x4*)op = o0; *(u32x4*)(op + 16) = o1; }
    LDS_WAIT(); asm volatile("" ::: "memory");
}
__device__ __forceinline__ void p0_prologue(Frame& F) {
    LAS float* scr = (LAS float*)(F.lds + F.wave * 16384);
    const int gw = F.vcu * NWAVES + F.wave, NGW = F.G * NWAVES;
    unsigned char* ws = F.ws;
    constexpr int I_IN = (DM / 64) * (2048 / 32), I_UP = (DM / 64) * (512 / 32), I_V8 = (DM / 64) * (1024 / 32), I_G8 = (DM / 64) * (3584 / 32), I_SQ = (DM / 64) * (DM / 32), I_BM = (512 / 64) * (DM / 32);
    constexpr int NITEMS = I_IN + I_UP + I_V8 + I_G8 + 3 * I_SQ + I_BM;
    for (int it = gw; it < NITEMS; it += NGW) {
        int r = it;
        if (r < I_IN) { transpose_item<1>(F.in[I_WIN], DM, 2048, IN_DIM, (bf16_t*)(ws + WS_WIN), nullptr, scr, r, F.lane); continue; } r -= I_IN;
        if (r < I_UP) { transpose_item<0>(F.in[I_WIN] + 3072, DM, 512, IN_DIM, (bf16_t*)(ws + WS_WIN) + (size_t)2048 * DM, nullptr, scr, r, F.lane); continue; } r -= I_UP;
        if (r < I_V8) { transpose_item8<0>(F.in[I_WIN] + 2048, DM, 1024, IN_DIM, ws + WS_WIN8, nullptr, scr, r, F.lane); continue; } r -= I_V8;
        if (r < I_G8) { transpose_item8<0>(F.in[I_WIN] + 3584, DM, 3584, IN_DIM, ws + WS_WIN8 + (size_t)1024 * DM, nullptr, scr, r, F.lane); continue; } r -= I_G8;
        if (r < I_SQ) { transpose_item<0>(F.in[I_WKV], DM, DM, DM, (bf16_t*)(ws + WS_WKV), nullptr, scr, r, F.lane); continue; } r -= I_SQ;
        if (r < I_SQ) { transpose_item<0>(F.in[I_WBA], DM, DM, DM, (bf16_t*)(ws + WS_WCAT), nullptr, scr, r, F.lane, BR_LD); continue; } r -= I_SQ;
        if (r < I_SQ) { transpose_item<0>(F.in[I_WOUT], DM, DM, DM, (bf16_t*)(ws + WS_WOUT), nullptr, scr, r, F.lane); continue; } r -= I_SQ;
        transpose_item<0>(F.in[I_WBM], 512, DM, DM, (bf16_t*)(ws + WS_WCAT) + BR_OM, nullptr, scr, r, F.lane, BR_LD);
    }
    { const float* pw = F.in[I_PW]; const float* ps = F.in[I_PS]; const float* wbp = F.in[I_WBP]; bf16_t* WE = (bf16_t*)(ws + WS_WCAT) + BR_Z;
      const int gt = F.vcu * 512 + F.tid, NGT = F.G * 512;
      for (int it = gt; it < 512 * (DM / 4); it += NGT) { const int d4 = it & (DM / 4 - 1), gc = it >> 8, g = gc >> 7;
          f32x4 a = {0.f, 0.f, 0.f, 0.f};
#pragma unroll 8
          for (int j = 0; j < 128; ++j) { const float c = pw[gc * 128 + j] * ps[g * 128 + j]; a += *(const f32x4*)(wbp + (size_t)(g * 128 + j) * DM + 4 * d4) * c; }
#pragma unroll
          for (int i = 0; i < 4; ++i) WE[(size_t)(4 * d4 + i) * BR_LD + gc] = (bf16_t)(cvtpk(a[i], 0.f) & 0xffffu); }
      float* cs = (float*)(ws + WS_ROPE); float* sn = cs + SEQ * 32;
      for (int it = gt; it < SEQ * 32; it += NGT) { const int pos = it >> 5, j = it & 31;
          const float invf = exp2f(-(float)(2 * j) * (1.0f / 64.0f) * 13.287712379549449f);
          const float ang = (float)pos * invf;
          const double rev = (double)ang * 0.15915494309189535; const float fr = (float)(rev - floor(rev));
          cs[it] = __builtin_amdgcn_cosf(fr); sn[it] = __builtin_amdgcn_sinf(fr); }
      { bf16_t* wr = (bf16_t*)(ws + WS_WR); const float* wrs = F.in[I_WR]; const float* gf = F.in[I_GFFN];
        for (int it = gt; it < DM * NE; it += NGT) { const int k = it >> 5, e = it & 31; const float w = gf[k] * wrs[it];
            const unsigned hi = cvtpk(w, 0.f) & 0xffffu; const float rem = w - __uint_as_float(hi << 16); const unsigned lo = cvtpk(rem, 0.f) & 0xffffu;
            const int off = (k >> 4) * 512 + ((k >> 3) & 1) * 256 + e * 8 + (k & 7);
            wr[off] = (bf16_t)hi; wr[32768 + off] = (bf16_t)lo; } }
    }
    { const float* X = F.in[I_X]; const float* gm = F.in[I_GMIX]; bf16_t* XN = (bf16_t*)(ws + WS_A);
      f32x4 nx[4];
#pragma unroll
      for (int j = 0; j < 4; ++j) nx[j] = ((const f32x4*)(X + (size_t)gw * DM) + F.lane)[64 * j];
      for (int m = gw; m < T; m += NGW) {
          f32x4 v[4]; float s = 0.f;
#pragma unroll
          for (int j = 0; j < 4; ++j) { v[j] = nx[j]; s += (v[j].x * v[j].x + v[j].y * v[j].y) + (v[j].z * v[j].z + v[j].w * v[j].w); }
          { const int mn = (m + NGW < T) ? m + NGW : m;
#pragma unroll
            for (int j = 0; j < 4; ++j) nx[j] = ((const f32x4*)(X + (size_t)mn * DM) + F.lane)[64 * j]; }
          const float rstd = __builtin_amdgcn_rsqf(wave_sum(s) * (1.f / DM) + EPS);
          u32x2* o8 = (u32x2*)(XN + (size_t)m * DM) + F.lane; unsigned* o4 = (unsigned*)(ws + WS_XN8 + (size_t)m * DM) + F.lane;
#pragma unroll
          for (int j = 0; j < 4; ++j) { const f32x4 g = ((const f32x4*)gm + F.lane)[64 * j]; const f32x4 y = v[j] * rstd * g;
              u32x2 w; w.x = cvtpk(y.x, y.y); w.y = cvtpk(y.z, y.w); o8[64 * j] = w; o4[64 * j] = cvt4_fp8(y.x, y.y, y.z, y.w); }
      } }
    for (int m = gw; m < TM; m += NGW) rms_row_to_bf16(F.in[I_MEM] + (size_t)m * DM, F.in[I_GMEM], (bf16_t*)(ws + WS_MEMN) + (size_t)m * DM, F.lane);
}

template <int W> __device__ __forceinline__ void pool_item(const bf16_t* U, bf16_t* Z, int t, int ch) {
    const int pos = t & (SEQ - 1);
    u32x4 c[W];
#pragma unroll
    for (int j = 0; j < W; ++j) { const int tj = (pos - j >= 0) ? t - j : t; c[j] = *(const u32x4*)(U + (size_t)tj * 512 + ch * 8); }
    float a[8] = {0.f, 0.f, 0.f, 0.f, 0.f, 0.f, 0.f, 0.f};
#pragma unroll
    for (int j = 0; j < W; ++j) { const float m = (pos - j >= 0) ? 1.0f : 0.0f;
        a[0] += m * bf_lo(c[j].x); a[1] += m * bf_hi(c[j].x); a[2] += m * bf_lo(c[j].y); a[3] += m * bf_hi(c[j].y); a[4] += m * bf_lo(c[j].z); a[5] += m * bf_hi(c[j].z); a[6] += m * bf_lo(c[j].w); a[7] += m * bf_hi(c[j].w); }
    const int cntw = (pos + 1 < W) ? pos + 1 : W; const float ic = 1.0f / (float)cntw;
    u32x4 o;
    o.x = cvtpk(a[0] * ic - bf_lo(c[0].x), a[1] * ic - bf_hi(c[0].x)); o.y = cvtpk(a[2] * ic - bf_lo(c[0].y), a[3] * ic - bf_hi(c[0].y));
    o.z = cvtpk(a[4] * ic - bf_lo(c[0].z), a[5] * ic - bf_hi(c[0].z)); o.w = cvtpk(a[6] * ic - bf_lo(c[0].w), a[7] * ic - bf_hi(c[0].w));
    *(u32x4*)(Z + (size_t)t * BR_LD + ch * 8) = o;
}
__device__ __forceinline__ void p2_pool(Frame& F) {
    const bf16_t* U = (const bf16_t*)(F.ws + WS_UP); bf16_t* Z = (bf16_t*)(F.ws + WS_A) + BR_Z;
    const int gw = F.vcu * NWAVES + F.wave, NGW = F.G * NWAVES;
    for (int it = gw; it < (T / 4) * 4; it += NGW) {
        const int g = it & 3, t = (it >> 2) * 4 + (F.lane >> 4), ch = g * 16 + (F.lane & 15);
        if (g == 0) pool_item<2>(U, Z, t, ch); else if (g == 1) pool_item<4>(U, Z, t, ch); else if (g == 2) pool_item<8>(U, Z, t, ch); else pool_item<16>(U, Z, t, ch);
    }
}

__device__ __forceinline__ void p5_router(Frame& F) {
    const bf16_t* H = (const bf16_t*)(F.ws + WS_A); const float* br = F.in[I_BR];
    unsigned* tslot = (unsigned*)(F.ws + WS_TSLOT); float* tw = (float*)(F.ws + WS_TW); float* rstd_o = (float*)(F.ws + WS_RSTD); unsigned* list = (unsigned*)(F.ws + WS_LIST); float* rslot = (float*)(F.ws + WS_RSLOT);
    { const u32x4* src = (const u32x4*)(F.ws + WS_WR); LAS u32x4* dst = (LAS u32x4*)F.lds;
      for (int i = F.tid; i < 131072 / 16; i += 512) dst[i] = src[i]; }
    volatile LAS unsigned* LC = F.MISC + MI_LC; volatile LAS unsigned* LB = F.MISC + MI_LB;
    WG_BAR();
    const int r32 = F.lane & 31, hi = F.lane >> 5;
    const LAS char* wa = (const LAS char*)F.lds + hi * 512 + r32 * 16;
    float bre[16];
#pragma unroll
    for (int r = 0; r < 16; ++r) bre[r] = br[(r & 3) + 8 * (r >> 2) + 4 * hi];
    for (int chunk = F.vcu; chunk < T / 256; chunk += F.G) {
        const int base = chunk * 256;
        if (F.tid < NE) LC[F.tid] = 0u;
        WG_BAR();
        const int row = base + F.wave * 32 + r32;
        const bf16_t* hp = H + (size_t)row * DM + hi * 8;
        f32x16 acc, acs;
#pragma unroll
        for (int r = 0; r < 16; ++r) { acc[r] = 0.f; acs[r] = 0.f; }
#pragma unroll 1
        for (int kb = 0; kb < 64; kb += 16) {
            bf16x8 hfr[16];
#pragma unroll
            for (int i = 0; i < 16; ++i) hfr[i] = *(const bf16x8*)(hp + (kb + i) * 16);
#pragma unroll
            for (int i = 0; i < 16; ++i) { const bf16x8 a0 = *(const LAS bf16x8*)(wa + (kb + i) * 1024), a1 = *(const LAS bf16x8*)(wa + 65536 + (kb + i) * 1024);
                acc = __builtin_amdgcn_mfma_f32_32x32x16_bf16(a0, hfr[i], acc, 0, 0, 0);
                acc = __builtin_amdgcn_mfma_f32_32x32x16_bf16(a1, hfr[i], acc, 0, 0, 0);
                acs = __builtin_amdgcn_mfma_f32_32x32x16_bf16(hfr[i], hfr[i], acs, 0, 0, 0); }
        }
        float dg = 0.f; { const int rsel = (r32 & 3) + 4 * (r32 >> 3);
#pragma unroll
            for (int r = 0; r < 16; ++r) dg = (rsel == r) ? acs[r] : dg; }
        { auto rr = __builtin_amdgcn_permlane32_swap(__float_as_uint(dg), __float_as_uint(dg), false, false); const float oth = (hi == 0) ? __uint_as_float(rr[1]) : __uint_as_float(rr[0]);
          dg = (hi == ((r32 >> 2) & 1)) ? dg : oth; }
        const float rstd = __builtin_amdgcn_rsqf(dg * (1.0f / DM) + EPS);
        float v[16];
#pragma unroll
        for (int r = 0; r < 16; ++r) v[r] = acc[r] * rstd + bre[r];
        float tv[8]; int te[8];
#pragma unroll
        for (int k = 0; k < 4; ++k) { float m = v[0]; int mi = 0;
#pragma unroll
            for (int r = 1; r < 16; ++r) { const bool g = v[r] > m; m = g ? v[r] : m; mi = g ? r : mi; }
            tv[k] = m; te[k] = (mi & 3) + 8 * (mi >> 2) + 4 * hi;
#pragma unroll
            for (int r = 0; r < 16; ++r) v[r] = (r == mi) ? -__builtin_inff() : v[r]; }
#pragma unroll
        for (int k = 0; k < 4; ++k) { auto a = __builtin_amdgcn_permlane32_swap(__float_as_uint(tv[k]), __float_as_uint(tv[k]), false, false); auto b = __builtin_amdgcn_permlane32_swap((unsigned)te[k], (unsigned)te[k], false, false);
            tv[4 + k] = (hi == 0) ? __uint_as_float(a[1]) : __uint_as_float(a[0]); te[4 + k] = (hi == 0) ? (int)b[1] : (int)b[0]; }
        float sv[4]; int se[4];
#pragma unroll
        for (int k = 0; k < 4; ++k) { float m = tv[0]; int me = te[0]; int mi = 0;
#pragma unroll
            for (int c = 1; c < 8; ++c) { const bool g = (tv[c] > m) || (tv[c] == m && te[c] < me); m = g ? tv[c] : m; me = g ? te[c] : me; mi = g ? c : mi; }
            sv[k] = m; se[k] = me;
#pragma unroll
            for (int c = 0; c < 8; ++c) tv[c] = (c == mi) ? -__builtin_inff() : tv[c]; }
        const float e1 = __expf(sv[1] - sv[0]), e2 = __expf(sv[2] - sv[0]), e3 = __expf(sv[3] - sv[0]); const float is = 1.0f / (1.0f + e1 + e2 + e3);
        unsigned myE = 0u, myR = 0u;
        if (hi == 0) {
#pragma unroll
            for (int k = 0; k < 4; ++k) { const unsigned rk = __hip_atomic_fetch_add((LAS unsigned*)&LC[se[k]], 1u, __ATOMIC_RELAXED, __HIP_MEMORY_SCOPE_WORKGROUP); myE |= (unsigned)se[k] << (8 * k); myR |= rk << (8 * k); }
            rstd_o[row] = rstd;
        }
        WG_BAR();
        if (F.tid < NE) LB[F.tid] = xb_add(F.ctl + CW_CNT + F.tid, LC[F.tid]);
        WG_BAR();
        if (hi == 0) {
            u32x4 ts; const f32x4 wv = {is, e1 * is, e2 * is, e3 * is};
#pragma unroll
            for (int k = 0; k < 4; ++k) { const unsigned e = (myE >> (8 * k)) & 0xffu, rnk = (myR >> (8 * k)) & 0xffu; const unsigned pos = LB[e] + rnk;
                ts[k] = (e << 24) | pos; list[(size_t)e * CAP + pos] = (unsigned)row; rslot[(size_t)e * CAP + pos] = rstd; }
            *(u32x4*)(tslot + (size_t)row * 4) = ts; *(f32x4*)(tw + (size_t)row * 4) = wv;
        }
        WG_BAR();
    }
}
__device__ __forceinline__ void p5_expert_weights(Frame& F) {
    LAS float* scr = (LAS float*)(F.lds + F.wave * 16384);
    const int gw = F.vcu * NWAVES + F.wave, NGW = F.G * NWAVES, lane = F.lane;
    constexpr int I_SQ = (DM / 64) * (DM / 32), NIT = 3 * NE * I_SQ;
    const float* gf = F.in[I_GFFN];
    f32x4 nx[8];
#define XW_SRC(it_, kk_) ({ const int mat_ = (it_) / I_SQ, r_ = (it_) % I_SQ, kind_ = mat_ / NE, e_ = mat_ % NE; const float* W_ = F.in[kind_ == 0 ? I_WG : (kind_ == 1 ? I_WU : I_WD)] + (size_t)e_ * DM * DM; \
        W_ + (size_t)(64 * (r_ / 32) + (kk_)) * DM + 32 * (r_ % 32) + (lane & 7) * 4; })
    if (gw < NIT) {
#pragma unroll
        for (int i = 0; i < 8; ++i) nx[i] = *(const f32x4*)XW_SRC(gw, 8 * i + (lane >> 3)); }
    for (int it = gw; it < NIT; it += NGW) {
        const int mat = it / I_SQ, r = it % I_SQ, kind = mat / NE, e = mat % NE, k0 = 64 * (r / 32), n0 = 32 * (r % 32);
#pragma unroll
        for (int i = 0; i < 8; ++i) { const int kk = 8 * i + (lane >> 3), nn = (lane & 7) * 4;
            const f32x4 v = nx[i] * (kind < 2 ? gf[k0 + kk] * W8_SCALE : W8_SCALE);
            LAS float* s = scr + kk * 33 + nn; s[0] = v[0]; s[1] = v[1]; s[2] = v[2]; s[3] = v[3]; }
        { const int itn = (it + NGW < NIT) ? it + NGW : it;
#pragma unroll
          for (int i = 0; i < 8; ++i) nx[i] = *(const f32x4*)XW_SRC(itn, 8 * i + (lane >> 3)); }
        LDS_WAIT(); asm volatile("" ::: "memory");
        { const int n = lane >> 1, kh = lane & 1; const LAS float* s = scr + (32 * kh) * 33 + n;
          u32x4 o0, o1;
          o0.x = cvt4_fp8(s[0 * 33], s[1 * 33], s[2 * 33], s[3 * 33]);     o0.y = cvt4_fp8(s[4 * 33], s[5 * 33], s[6 * 33], s[7 * 33]);
          o0.z = cvt4_fp8(s[8 * 33], s[9 * 33], s[10 * 33], s[11 * 33]);   o0.w = cvt4_fp8(s[12 * 33], s[13 * 33], s[14 * 33], s[15 * 33]);
          o1.x = cvt4_fp8(s[16 * 33], s[17 * 33], s[18 * 33], s[19 * 33]); o1.y = cvt4_fp8(s[20 * 33], s[21 * 33], s[22 * 33], s[23 * 33]);
          o1.z = cvt4_fp8(s[24 * 33], s[25 * 33], s[26 * 33], s[27 * 33]); o1.w = cvt4_fp8(s[28 * 33], s[29 * 33], s[30 * 33], s[31 * 33]);
          const int nrow = n0 + n; const int orow = kind == 0 ? rowmap<2>(nrow) : (kind == 1 ? rowmap<3>(nrow) : nrow);
          unsigned char* op = (kind < 2 ? F.ws + WS_WGU8 + (size_t)e * 2048 * DM : F.ws + WS_WD8 + (size_t)e * DM * DM) + (size_t)orow * DM + k0 + 32 * kh;
          *(u32x4*)op = o0; *(u32x4*)(op + 16) = o1; }
        LDS_WAIT(); asm volatile("" ::: "memory");
    }
#undef XW_SRC
}
__device__ __forceinline__ void moe_tables(Frame& F) {
    WG_BAR();
    if (F.wave == 0) {
        const int n = F.lane < NE ? (int)xb_ld(F.ctl + CW_CNT + F.lane) : 0; const int nb = (n + 255) >> 8; int x = nb;
#pragma unroll
        for (int o = 1; o < 32; o <<= 1) { const int t = __shfl_up(x, o); if (F.lane >= o) x += t; }
        if (F.lane < NE) { F.MISC[MI_CNT + F.lane] = (unsigned)n; F.MISC[MI_CUM + F.lane] = (unsigned)(x - nb);
            for (int rb = x - nb; rb < x; ++rb) F.MISC[MI_RB + rb] = (unsigned)F.lane; }
        if (F.lane == NE - 1) F.MISC[MI_CUM + NE] = (unsigned)x;
    }
    WG_BAR();
}
__device__ __forceinline__ void moe_combine(Frame& F) {
    const unsigned* tslot = (const unsigned*)(F.ws + WS_TSLOT); const float* tw = (const float*)(F.ws + WS_TW); const unsigned char* OS = F.ws + WS_OSLOT;
    const int gw = F.vcu * NWAVES + F.wave, NGW = F.G * NWAVES;
    u32x4 tsn = *(const u32x4*)(tslot + (size_t)gw * 4); f32x4 wvn = *(const f32x4*)(tw + (size_t)gw * 4);
    for (int t = gw; t < T; t += NGW) {
        const u32x4 ts = tsn; const f32x4 wv = wvn;
        { const int tn = (t + NGW < T) ? t + NGW : t; tsn = *(const u32x4*)(tslot + (size_t)tn * 4); wvn = *(const f32x4*)(tw + (size_t)tn * 4); }
        f32x4 a[4]; float* op = F.out + (size_t)t * DM + 4 * F.lane;
        { const bf16_t* hp = (const bf16_t*)(F.ws + WS_A) + (size_t)t * DM + 4 * F.lane;
#pragma unroll
          for (int j = 0; j < 4; ++j) { const u32x2 v = *(const u32x2*)(hp + 256 * j); a[j][0] = bf_lo(v.x); a[j][1] = bf_hi(v.x); a[j][2] = bf_lo(v.y); a[j][3] = bf_hi(v.y); } }
#pragma unroll
        for (int k = 0; k < 4; ++k) { const unsigned e = ts[k] >> 24, pos = ts[k] & 0xffffffu; const size_t prow = (size_t)F.MISC[MI_CUM + e] * 256 + pos; const float w = wv[k] * (1.0f / OS_SCALE);
            const unsigned char* rp = OS + prow * DM + 4 * F.lane;
#pragma unroll
            for (int j = 0; j < 4; ++j) { const int v = *(const int*)(rp + 256 * j); const f32x2 lo = __builtin_amdgcn_cvt_pk_f32_fp8(v, false), hi = __builtin_amdgcn_cvt_pk_f32_fp8(v, true);
                a[j][0] += w * lo.x; a[j][1] += w * lo.y; a[j][2] += w * hi.x; a[j][3] += w * hi.y; } }
#pragma unroll
        for (int j = 0; j < 4; ++j) *(f32x4*)(op + 256 * j) = a[j];
    }
}
#ifndef MK_SPLIT
#define MK_SPLIT 0
#endif
constexpr int N_PHASES = 9;
#ifndef MK_P2_REP_A
#define MK_P2_REP_A 1
#define MK_P2_REP_B 1
#define MK_P2_REP_C 1
#endif
#ifndef MK_REP_MASK
#define MK_REP_MASK 0
#endif
struct Args { const float* in[31]; float* out; unsigned char* ws; int ph_lo, ph_hi; };
static_assert(sizeof(Args) == 31 * 8 + 8 + 8 + 8, "no padding bytes in Args");

__global__ void __launch_bounds__(NWAVES * 64, 2) mk_fwd(Args args) {
    extern __shared__ __attribute__((aligned(16))) unsigned char lds_raw[];
    const int lo = args.ph_lo, hi = args.ph_hi;
    const int wave_s = __builtin_amdgcn_readfirstlane((int)threadIdx.x >> 6);
    XcdBarrier bar;
    { MKFRAME(F0);
      for (int u = F0.tid; u < (LDS_BYTES - MISC_OFF) / 4; u += NWAVES * 64) ((LAS unsigned*)(F0.lds + MISC_OFF))[u] = 0u;
      __syncthreads();
      bar.bar = F0.ctl + CW_BAR; bar.x = 0; bar.st = nullptr;
      if (!MK_SPLIT) bar = xcd_barrier_post(F0.ctl + CW_BAR, F0.MISC + 8); }
#define IN(k) (lo <= (k) && (k) < hi)
#define SEAM(k) do { if (!MK_SPLIT && IN(k) && IN((k) + 1)) xcd_barrier(bar); } while (0)
#define XA_(F) ((bf16_t*)((F).ws + WS_A))
#define QB_(F) ((bf16_t*)(F).out)
#define KB_(F) ((bf16_t*)(F).out + (size_t)T * DM)
#define VB_(F) ((bf16_t*)((F).ws + WS_V))
#define GT_(F) ((bf16_t*)((F).ws + WS_GATES))

    if (IN(0)) { MKFRAME(F); p0_prologue(F); }
    SEAM(0);

    if (IN(1)) {
        { MKFRAME(F);
          pg8::ABPlain g{XA_(F), (const bf16_t*)(F.ws + WS_WIN), DM}; pg8::StaticOrder S; S.init(T, 2560, F.G, (int)blockIdx.x);
          epi::EpiInProj E{QB_(F), KB_(F), VB_(F), (bf16_t*)(F.ws + WS_UP), (bf16_t*)(F.ws + WS_QM), GT_(F), F.in[I_QN], F.in[I_KN], (const float*)(F.ws + WS_ROPE), (const float*)(F.ws + WS_ROPE) + SEQ * 32, F.in[I_BG], 0, 1.0f};
          pg8::gemm_phase<epi::EpiInProj, pg8::StaticOrder, pg8::ABPlain, true, true>(F.tid, F.lds, g, S, E); }
        WG_BAR();
        { MKFRAME(F);
          pg8::ABPlain8 g{(const bf16_t*)(F.ws + WS_XN8), (const bf16_t*)(F.ws + WS_WIN8), DM / 2}; pg8::StaticOrder S; S.init(T, 4608, F.G, (int)blockIdx.x);
          epi::EpiInProj E{QB_(F), KB_(F), VB_(F), (bf16_t*)(F.ws + WS_UP), (bf16_t*)(F.ws + WS_QM), GT_(F), F.in[I_QN], F.in[I_KN], (const float*)(F.ws + WS_ROPE), (const float*)(F.ws + WS_ROPE) + SEQ * 32, F.in[I_BG], 1, 1.0f / W8_SCALE};
          pg8::gemm_phase<epi::EpiInProj, pg8::StaticOrder, pg8::ABPlain8, true, true>(F.tid, F.lds, g, S, E); }
        WG_BAR();
        { MKFRAME(F);
          pg8::ABPlain g{(const bf16_t*)(F.ws + WS_MEMN), (const bf16_t*)(F.ws + WS_WKV), DM}; pg8::StaticOrder S; S.init(TM, DM, F.G, (int)blockIdx.x);
          epi::EpiMemKV E{(bf16_t*)(F.ws + WS_KM), (bf16_t*)(F.ws + WS_VM), F.in[I_MK], F.in[I_MQ]};
          if (F.G >= 64) pg8::gemm_phase<epi::EpiMemKV, pg8::StaticOrder, pg8::ABPlain, false, true>(F.tid, F.lds, g, S, E); }
        WG_BAR();
    }
    SEAM(1);

    if (IN(2)) {
#pragma unroll 1
        for (int rep_ = 0; rep_ < MK_P2_REP_A; ++rep_)
        { MKFRAME(F);
          float lam;
          { const float a = F.in[I_LQ1][F.lane] * F.in[I_LK1][F.lane], b = F.in[I_LQ2][F.lane] * F.in[I_LK2][F.lane];
            lam = __expf(wave_sum(a)) - __expf(wave_sum(b)) + LAMBDA_INIT; }
          const float* gsub = F.in[I_GSUB];
#pragma unroll 1
          for (int P = F.vcu; P < BATCH * 8 * 16; P += F.G) {
#pragma unroll 1
              for (int s = 0; s < 2; ++s) { const int bh = P >> 4, p = P & 15, qb = s ? 31 - p : p;
                  att::da_unit(F.tid, bh >> 3, bh & 7, qb, QB_(F), KB_(F), VB_(F), XA_(F), BR_LD, lam, gsub, F.lds); }
          } }
#pragma unroll 1
        for (int rep_ = 0; rep_ < MK_P2_REP_B; ++rep_)
        { MKFRAME(F); p2_pool(F); }
#pragma unroll 1
        for (int rep_ = 0; rep_ < MK_P2_REP_C; ++rep_)
        { MKFRAME(F);
#pragma unroll 1
          for (int U = F.vcu; U < BATCH * 4 * 4; U += F.G)
              att::ca_unit(F.tid, U >> 4, (U >> 2) & 3, U & 3, (const bf16_t*)(F.ws + WS_QM), (const bf16_t*)(F.ws + WS_KM), (const bf16_t*)(F.ws + WS_VM), XA_(F) + BR_OM, BR_LD, F.lds); }
    }
    SEAM(2);

    if (IN(3)) {
        MKFRAME(F); pg8::ABPlain g{XA_(F), (const bf16_t*)(F.ws + WS_WCAT), BR_LD}; pg8::StaticOrder S; S.init(T, DM, F.G, (int)blockIdx.x);
        epi::EpiMerge3 E{GT_(F), VB_(F)};
        pg8::gemm_phase<epi::EpiMerge3, pg8::StaticOrder, pg8::ABPlain, true, true>(F.tid, F.lds, g, S, E);
        WG_BAR();
    }
    SEAM(3);

    if (IN(4)) {
        MKFRAME(F); pg8::ABPlain g{VB_(F), (const bf16_t*)(F.ws + WS_WOUT), DM}; pg8::StaticOrder S; S.init(T, DM, F.G, (int)blockIdx.x);
        epi::EpiOut E{F.in[I_X], XA_(F), F.ws + WS_HB8};
        pg8::gemm_phase<epi::EpiOut, pg8::StaticOrder, pg8::ABPlain, true, true>(F.tid, F.lds, g, S, E);
        WG_BAR();
    }
    SEAM(4);

    if (IN(5)) { { MKFRAME(F); p5_router(F); } WG_BAR(); { MKFRAME(F); p5_expert_weights(F); } }
    SEAM(5);

    if (IN(6)) {
        MKFRAME(F);
        const unsigned* list = (const unsigned*)(F.ws + WS_LIST);
        moe_tables(F);
        pg8::ABMoeGU g{(const bf16_t*)(F.ws + WS_HB8), (const bf16_t*)(F.ws + WS_WGU8), list, DM / 2};
        pg8::MoeOrder S{(const volatile LAS int*)(F.MISC + MI_CNT), (const volatile LAS int*)(F.MISC + MI_CUM), (const volatile LAS int*)(F.MISC + MI_RB), 8, F.G, F.vcu, (int)F.MISC[MI_CUM + NE] * 8};
        epi::EpiGateUp E{(const float*)(F.ws + WS_RSLOT), F.in[I_BGATE], F.in[I_BUP], F.ws + WS_ACT8};
        pg8::gemm_phase<epi::EpiGateUp, pg8::MoeOrder, pg8::ABMoeGU, true, true>(F.tid, F.lds, g, S, E);
        WG_BAR();
    }
    SEAM(6);
    if (IN(7)) {
        MKFRAME(F);
        moe_tables(F);
        pg8::ABMoeDown g{(const bf16_t*)(F.ws + WS_ACT8), (const bf16_t*)(F.ws + WS_WD8), DM / 2};
        pg8::MoeOrder S{(const volatile LAS int*)(F.MISC + MI_CNT), (const volatile LAS int*)(F.MISC + MI_CUM), (const volatile LAS int*)(F.MISC + MI_RB), 4, F.G, F.vcu, (int)F.MISC[MI_CUM + NE] * 4};
        epi::EpiDown E{F.in[I_BDOWN], F.ws + WS_OSLOT};
        pg8::gemm_phase<epi::EpiDown, pg8::MoeOrder, pg8::ABMoeDown, true, true>(F.tid, F.lds, g, S, E);
        WG_BAR();
    }
    SEAM(7);
    if (IN(8)) { MKFRAME(F); moe_tables(F); moe_combine(F); }
#undef IN
#undef SEAM
}

extern "C" void kernel_launch(void* const* d_in, const int* in_sizes, int n_in, void* d_out, int out_size, void* d_ws, size_t ws_size, hipStream_t stream) {
    static int grid = 0;
    if (grid == 0) {
        if (n_in != 31 || in_sizes[0] != T * DM || out_size != T * DM || ws_size < WS_END) { fprintf(stderr, "kernel_launch: unexpected shapes (n_in %d, in0 %d, out %d, ws %zu)\n", n_in, n_in > 0 ? in_sizes[0] : -1, out_size, ws_size); grid = -1; return; }
        int dev = 0, cus = 0, per_cu = 0;
        if (hipGetDevice(&dev) != hipSuccess || hipDeviceGetAttribute(&cus, hipDeviceAttributeMultiprocessorCount, dev) != hipSuccess) { grid = -1; return; }
        if (hipFuncSetAttribute((const void*)mk_fwd, hipFuncAttributeMaxDynamicSharedMemorySize, LDS_BYTES) != hipSuccess) { fprintf(stderr, "kernel_launch: hipFuncSetAttribute failed\n"); grid = -1; return; }
        if (hipOccupancyMaxActiveBlocksPerMultiprocessor(&per_cu, (const void*)mk_fwd, NWAVES * 64, LDS_BYTES) != hipSuccess || per_cu < 1) fprintf(stderr, "kernel_launch: occupancy query reports %d\n", per_cu);
        (void)hipGetLastError();
        grid = cus;
    }
    if (grid < 0) return;
    (void)hipMemsetAsync((char*)d_ws + WS_CTL, 0, CTL_ZERO_BYTES, stream);
    Args a{};
    for (int i = 0; i < 31; ++i) a.in[i] = (const float*)d_in[i];
    a.out = (float*)d_out; a.ws = (unsigned char*)d_ws;
#if MK_SPLIT
    for (int p = 0; p < N_PHASES; ++p) { const int reps = ((MK_REP_MASK >> p) & 1) ? 2 : 1;
        for (int r = 0; r < reps; ++r) { if (p == 5 && r > 0) (void)hipMemsetAsync((char*)d_ws + WS_CTL + CW_CNT * 4, 0, NE * 4, stream);
            a.ph_lo = p; a.ph_hi = p + 1; hipLaunchKernelGGL(mk_fwd, dim3(grid), dim3(NWAVES * 64), LDS_BYTES, stream, a); } }
#else
    a.ph_lo = 0; a.ph_hi = N_PHASES;
    hipLaunchKernelGGL(mk_fwd, dim3(grid), dim3(NWAVES * 64), LDS_BYTES, stream, a);
#endif
    const hipError_t le = hipPeekAtLastError();
    if (le != hipSuccess) fprintf(stderr, "kernel_launch: launch failed: %s\n", hipGetErrorName(le));
}
```

```cpp
#include <hip/hip_runtime.h>
#ifndef GP_PROF
#define GP_PROF 0
#endif
#ifndef DA_PROF
#define DA_PROF 0
#endif
#include <cstdio>
#include <cstdint>

#define GAS __attribute__((address_space(1)))
#define LAS __attribute__((address_space(3)))
typedef unsigned short bf16_t;
typedef short bf16x8 __attribute__((ext_vector_type(8)));
typedef short s16x4 __attribute__((ext_vector_type(4)));
typedef float f32x2 __attribute__((ext_vector_type(2)));
typedef float f32x4 __attribute__((ext_vector_type(4)));
typedef float f32x16 __attribute__((ext_vector_type(16)));
typedef unsigned u32x2 __attribute__((ext_vector_type(2)));
typedef unsigned u32x4 __attribute__((ext_vector_type(4)));
typedef __bf16 bf16x2_t __attribute__((ext_vector_type(2)));

constexpr int BATCH = 16, SEQ = 4096, DM = 1024, T = BATCH * SEQ;
constexpr int IN_DIM = 7168, MEMLEN = 256, TM = BATCH * MEMLEN;
constexpr int NE = 32, TOPK = 4, CAP = T;
constexpr float EPS = 1e-6f;
constexpr float LAMBDA_INIT = 0.2f;
constexpr float LOG2E = 1.4426950408889634f;
constexpr float C2 = 0.125f * LOG2E;
constexpr float C3 = 0.08838834764831845f * LOG2E;
constexpr int NWAVES = 8;

constexpr size_t MiB = 1u << 20;
constexpr size_t WS_CTL = 0, CTL_ZERO_BYTES = 64 * 1024;
constexpr size_t WS_WIN = 2 * MiB;
constexpr size_t WS_WIN8 = 8 * MiB;
constexpr size_t WS_WKV = 16 * MiB;
constexpr size_t WS_WCAT = 18 * MiB;
constexpr size_t WS_WOUT = 22 * MiB;
constexpr size_t WS_ROPE = 24 * MiB;
constexpr size_t WS_WR = 25 * MiB;
constexpr size_t WS_MEMN = 26 * MiB;
constexpr size_t WS_KM = 34 * MiB;
constexpr size_t WS_VM = 38 * MiB;
constexpr size_t WS_TSLOT = 42 * MiB;
constexpr size_t WS_TW = 43 * MiB;
constexpr size_t WS_RSTD = 44 * MiB;
constexpr size_t WS_LIST = 46 * MiB;
constexpr size_t WS_RSLOT = 54 * MiB;
constexpr size_t WS_A = 64 * MiB;
constexpr size_t WS_GATES = 320 * MiB;
constexpr size_t WS_V = 704 * MiB;
constexpr size_t WS_UP = 832 * MiB;
constexpr size_t WS_QM = 896 * MiB;
constexpr int BR_LD = 2048, BR_Z = 1024, BR_OM = 1536;
constexpr size_t WS_XN8 = 960 * MiB;
constexpr size_t WS_WGU8 = 192 * MiB;
constexpr size_t WS_WD8 = 256 * MiB;
constexpr size_t WS_HB8 = 288 * MiB;
constexpr size_t WS_ACT8 = 352 * MiB;
constexpr size_t WS_OSLOT = 616 * MiB;
constexpr int PMAX = T * TOPK + NE * 256;
constexpr size_t WS_END = 1024 * MiB;
constexpr float W8_SCALE = 128.0f, ACT_SCALE = 4.0f, OS_SCALE = 16.0f;
static_assert(WS_ACT8 + (size_t)PMAX * DM <= WS_OSLOT && WS_OSLOT + (size_t)PMAX * DM <= WS_END, "moe buffers");
static_assert(WS_LIST + (size_t)NE * CAP * 4 <= WS_RSLOT && WS_RSLOT + (size_t)NE * CAP * 4 <= WS_A, "list");
constexpr int CW_TMO = 0, CW_BAR = 4096, CW_CNT = 8192;

constexpr int RING_BYTES = 131072;
constexpr int WSF_OFF = RING_BYTES;
constexpr int MISC_OFF = WSF_OFF + 2048;
constexpr int LDS_BYTES = 147456;
constexpr int EPB_OFF = MISC_OFF + 8192;

#define RLX_AGENT __ATOMIC_RELAXED, __HIP_MEMORY_SCOPE_AGENT
#define LDS_WAIT() asm volatile("s_waitcnt lgkmcnt(0)" ::: "memory")
#define VM_WAIT() asm volatile("s_waitcnt vmcnt(0)" ::: "memory")
#define WG_BAR() asm volatile("s_waitcnt vmcnt(0) lgkmcnt(0)\n\ts_barrier" ::: "memory")

__device__ __forceinline__ unsigned cvtpk(float lo, float hi) { f32x2 v = {lo, hi}; bf16x2_t b = __builtin_convertvector(v, bf16x2_t); return __builtin_bit_cast(unsigned, b); }
__device__ __forceinline__ unsigned cvt4_fp8(float a, float b, float c, float d) { int r = __builtin_amdgcn_cvt_pk_fp8_f32(a, b, 0, false); r = __builtin_amdgcn_cvt_pk_fp8_f32(c, d, r, true); return (unsigned)r; }
__device__ __forceinline__ float clamp_fp8(float x) { return __builtin_amdgcn_fmed3f(x, -448.0f, 448.0f); }
__device__ __forceinline__ float bf_lo(unsigned w) { return __uint_as_float(w << 16); }
__device__ __forceinline__ float bf_hi(unsigned w) { return __uint_as_float(w & 0xffff0000u); }
__device__ __forceinline__ float wave_sum(float v) {
#pragma unroll
    for (int o = 1; o < 64; o <<= 1) v += __shfl_xor(v, o);
    return v;
}
__device__ __forceinline__ float fast_sigmoid(float x) { return __builtin_amdgcn_rcpf(1.0f + __builtin_amdgcn_exp2f(-LOG2E * x)); }
namespace pg8 {
constexpr int BM = 256, BK = 64, HALF = 128, HTB = HALF * BK * 2  , STAGE_BYTES = 8 * HTB, NXCD = 8, WGM = 8;

__host__ __device__ __forceinline__ int lds_byte(int r, int c) { const int st = (r >> 4) * 2 + (c >> 5), rr = r & 15, cc = c & 31, ob = rr * 64 + cc * 2; return st * 1024 + (ob ^ (((ob >> 9) & 1) << 5)); }
__host__ __device__ __forceinline__ void stage_rc(int b, int& R, int& C) { const int st = b / 1024, sb = b % 1024, swz = sb ^ (((sb >> 9) & 1) << 5); R = (st >> 1) * 16 + swz / 64; C = (st & 1) * 32 + (swz % 64) / 2; }
__host__ __device__ __forceinline__ int perm32(int rho) { const int n = rho >> 4, i = rho & 15; return 8 * (i >> 2) + 4 * n + (i & 3); }

struct Unit { int pm, pn, e, rb, nvalid; };

struct StaticOrder {
    int nM, nN, nwg, G, c;
    __device__ void init(int M, int N, int G_, int c_) { nM = M / BM; nN = N / BM; nwg = nM * nN; G = G_; c = c_; }
    __device__ bool next(int i, Unit& u) const {
        const long L = (long)i * G + c; if (L >= nwg) return false;
        int wgid = (int)L; { const int q = nwg / NXCD, r = nwg % NXCD, xcd = wgid % NXCD, off = wgid / NXCD; wgid = (xcd < r ? xcd * (q + 1) : r * (q + 1) + (xcd - r) * q) + off; }
        const int nig = WGM * nN, gid = wgid / nig, fm = gid * WGM, gsz = (nM - fm) < WGM ? (nM - fm) : WGM;
        u.pm = fm + ((wgid % nig) % gsz); u.pn = (wgid % nig) / gsz; u.e = 0; u.rb = 0; u.nvalid = 256; return true;
    }
};

struct ABPlain {
    static constexpr bool GATHER = false, FP8 = false;
    const bf16_t* A; const bf16_t* Bt; int K;
    __device__ __forceinline__ const char* a_base(const Unit& u) const { return (const char*)A + (size_t)u.pm * BM * K * 2; }
    __device__ __forceinline__ const char* b_base(const Unit& u) const { return (const char*)Bt + (size_t)u.pn * BM * K * 2; }
    __device__ __forceinline__ unsigned a_off(const Unit&, int r, int c) const { return (unsigned)(r * K + c) * 2u; }
};

struct ABPlain8 {
    static constexpr bool GATHER = false, FP8 = true;
    const bf16_t* A; const bf16_t* Bt; int K;
    __device__ __forceinline__ const char* a_base(const Unit& u) const { return (const char*)A + (size_t)u.pm * BM * K * 2; }
    __device__ __forceinline__ const char* b_base(const Unit& u) const { return (const char*)Bt + (size_t)u.pn * BM * K * 2; }
    __device__ __forceinline__ unsigned a_off(const Unit&, int r, int c) const { return (unsigned)(r * K + c) * 2u; }
};

typedef int v8i_ __attribute__((ext_vector_type(8))); typedef int v4i_ __attribute__((ext_vector_type(4)));
template <class Epi, class Sched, class AB, bool ALIGN_EPI, bool SP2>
__device__ __forceinline__ void gemm_phase(const int tid, LAS unsigned char* lds, const AB& g, const Sched& S, const Epi& E) {
    static_assert(SP2, "only the SP2 loop is kept");
    const int wid = __builtin_amdgcn_readfirstlane(tid >> 6), lane = tid & 63, wr = wid >> 2, wc = wid & 3, fr = lane & 15, fq = lane >> 4;
    const int K = g.K, nt = K / BK;
    unsigned voffB[2]; int rA[2], cA_[2];
#pragma unroll
    for (int i = 0; i < 2; ++i) { int R, C; stage_rc(tid * 16 + i * 8192, R, C); const int Rb = Epi::PERM ? ((R & ~31) + perm32(R & 31)) : R;
        rA[i] = R; cA_[i] = C; voffB[i] = (unsigned)(Rb * K + C) * 2u; }
    const size_t kstep = (size_t)(BK * 2);
    const size_t hstep = (size_t)HALF * K * 2;
    const unsigned ldsw = (unsigned)wid * 1024u;
    const int aoff = lds_byte(wr * 64 + fr, fq * 8), boff = lds_byte(wc * 32 + fr, fq * 8);
#define PG8_SA(b, h) (((b) * 2 + (h)) * HTB)
#define PG8_SB(b, h) ((4 + (b) * 2 + (h)) * HTB)
#define PG8_STAGE(bufoff, gbase, voff) do { _Pragma("unroll") for (int _i = 0; _i < 2; ++_i) \
        __builtin_amdgcn_global_load_lds((const unsigned*)((const char*)(gbase) + (voff)[_i]), (LAS unsigned*)(lds + (bufoff) + ldsw + _i * 8192), 16, 0, 0); } while (0)
#define PG8_LDA(dst, b, h) do { _Pragma("unroll") for (int m = 0; m < 4; ++m) { const v4i_ x0_ = *(const LAS v4i_*)(lds + PG8_SA(b, h) + aoff + m * 2048), x1_ = *(const LAS v4i_*)(lds + PG8_SA(b, h) + aoff + m * 2048 + 1024); \
        dst[m] = __builtin_shufflevector(x0_, x1_, 0, 1, 2, 3, 4, 5, 6, 7); } } while (0)
#define PG8_LDB(dst, b, h) do { _Pragma("unroll") for (int n = 0; n < 2; ++n) { const v4i_ x0_ = *(const LAS v4i_*)(lds + PG8_SB(b, h) + boff + n * 2048), x1_ = *(const LAS v4i_*)(lds + PG8_SB(b, h) + boff + n * 2048 + 1024); \
        dst[n] = __builtin_shufflevector(x0_, x1_, 0, 1, 2, 3, 4, 5, 6, 7); } } while (0)
#define PG8_MMAX(ai, bj, At, Bt, FIRST) do { __builtin_amdgcn_s_setprio(1); _Pragma("unroll") for (int m = 0; m < 4; ++m) _Pragma("unroll") for (int n = 0; n < 2; ++n) { \
        if constexpr (AB::FP8) { if constexpr ((FIRST) != 0) asm volatile("v_mfma_f32_16x16x128_f8f6f4 %0, %1, %2, 0" : "=&v"(acc[ai][bj][m][n]) : "v"(Bt[n]), "v"(At[m])); \
                                 else asm volatile("v_mfma_f32_16x16x128_f8f6f4 %0, %1, %2, %0" : "+v"(acc[ai][bj][m][n]) : "v"(Bt[n]), "v"(At[m])); } \
        else { acc[ai][bj][m][n] = __builtin_amdgcn_mfma_f32_16x16x32_bf16(__builtin_bit_cast(bf16x8, __builtin_shufflevector(Bt[n], Bt[n], 0, 1, 2, 3)), __builtin_bit_cast(bf16x8, __builtin_shufflevector(At[m], At[m], 0, 1, 2, 3)), ((FIRST) != 0) ? (f32x4){0.f, 0.f, 0.f, 0.f} : acc[ai][bj][m][n], 0, 0, 0); \
               acc[ai][bj][m][n] = __builtin_amdgcn_mfma_f32_16x16x32_bf16(__builtin_bit_cast(bf16x8, __builtin_shufflevector(Bt[n], Bt[n], 4, 5, 6, 7)), __builtin_bit_cast(bf16x8, __builtin_shufflevector(At[m], At[m], 4, 5, 6, 7)), acc[ai][bj][m][n], 0, 0, 0); } } \
        __builtin_amdgcn_s_setprio(0); } while (0)
#define PG8_MMA(ai, bj, At, Bt) PG8_MMAX(ai, bj, At, Bt, 0)
#define PG8_WAIT_V(n) asm volatile("s_waitcnt vmcnt(" #n ")" ::: "memory")
#define PG8_WAIT_L(n) asm volatile("s_waitcnt lgkmcnt(" #n ")" ::: "memory")
#define PG8_BAR __builtin_amdgcn_s_barrier()
#define PG8_SCHED __builtin_amdgcn_sched_barrier(0)
    Unit cur, nxt; int ui = 0;
    if (!S.next(0, cur)) return;
#if GP_PROF
    unsigned gk0_ = 0, gk1_ = 0, gk1b_ = 0, gk2_ = 0;
#define GP_TS(v) do { v = (unsigned)__builtin_amdgcn_s_memrealtime(); __builtin_amdgcn_sched_barrier(0); } while (0)
#define GP_ACC() do { if (wid == 0 && lane == 0) { volatile LAS unsigned* pf_ = (volatile LAS unsigned*)(lds + MISC_OFF) + 3320; pf_[0] += gk1_ - gk0_; pf_[1] += gk2_ - gk1_; pf_[2] += 1u; pf_[3] += gk1b_ - gk1_; } } while (0)
#else
#define GP_TS(v) do { } while (0)
#define GP_ACC() do { } while (0)
#endif
    f32x4 acc[2][2][4][2];
    v8i_ At[4], B0[2], B1[2];
    unsigned vA0[2], vA1[2], tk[4] = {0u, 0u, 0u, 0u};
#pragma unroll
    for (int i = 0; i < 2; ++i) { vA0[i] = g.a_off(cur, rA[i], cA_[i]); vA1[i] = g.a_off(cur, HALF + rA[i], cA_[i]); }
    const char* cA = g.a_base(cur); const char* cB = g.b_base(cur);
    PG8_STAGE(PG8_SB(0, 0), cB, voffB); PG8_STAGE(PG8_SB(0, 1), cB + hstep, voffB); PG8_STAGE(PG8_SA(0, 0), cA, vA0); PG8_STAGE(PG8_SA(0, 1), cA, vA1);
    if (wr == 1) PG8_BAR;
    PG8_WAIT_V(2); PG8_BAR;
    PG8_STAGE(PG8_SB(1, 0), cB + kstep, voffB); PG8_STAGE(PG8_SA(1, 0), cA + kstep, vA0); PG8_STAGE(PG8_SB(1, 1), cB + hstep + kstep, voffB);
    PG8_WAIT_V(6); PG8_BAR;
    for (;;) {
        const bool has_next = S.next(ui + 1, nxt);
        if constexpr (Epi::PREFETCH) E.prefetch(cur, lds + EPB_OFF + (ui & 1) * 2048, wid, lane);
        const char* nA = has_next ? g.a_base(nxt) : cA; const char* nB = has_next ? g.b_base(nxt) : cB;
        if constexpr (AB::GATHER) {
            if (has_next) {
#pragma unroll
                for (int i = 0; i < 2; ++i) {
                    asm volatile("global_load_dword %0, %1, off" : "=v"(tk[i]) : "v"(g.tok_ptr(nxt, rA[i])) : "memory");
                    asm volatile("global_load_dword %0, %1, off" : "=v"(tk[2 + i]) : "v"(g.tok_ptr(nxt, HALF + rA[i])) : "memory");
                }
            }
        }
        GP_TS(gk0_);
#define PG8_KITER(t, FIRST_) do { \
            if constexpr (Epi::HOOKS) { if (t == Epi::HOOK1 || t == Epi::HOOK2) E.hook(acc, cur, t, wr, wc, fr, fq); } \
            const bool last = (t == nt - 2); \
            const char* a1 = cA + (size_t)(t + 1) * kstep; \
            const char* a2 = last ? nA : cA + (size_t)(t + 2) * kstep; const char* b2 = last ? nB : cB + (size_t)(t + 2) * kstep; \
            const char* a3 = a2 + kstep; const char* b3 = b2 + kstep; \
            unsigned w0[2], w1[2]; \
_Pragma("unroll")             for (int i = 0; i < 2; ++i) { w0[i] = vA0[i]; w1[i] = vA1[i]; } \
            if constexpr (AB::GATHER) { \
                if (last && has_next) { \
                    asm volatile("s_waitcnt vmcnt(8)" : "+v"(tk[0]), "+v"(tk[1]), "+v"(tk[2]), "+v"(tk[3]) :: "memory"); \
_Pragma("unroll")                     for (int i = 0; i < 2; ++i) { w0[i] = g.off_from_tok(tk[i], cA_[i]); w1[i] = g.off_from_tok(tk[2 + i], cA_[i]); } \
                } \
            } \
            PG8_LDB(B0, 0, 0); PG8_LDB(B1, 0, 1); PG8_SCHED; PG8_LDA(At, 0, 0); PG8_STAGE(PG8_SA(1, 1), a1, vA1); \
            PG8_WAIT_V(8); PG8_WAIT_L(0); PG8_BAR; PG8_MMAX(0, 0, At, B0, FIRST_); PG8_MMAX(0, 1, At, B1, FIRST_); PG8_BAR; PG8_SCHED; \
            PG8_LDA(At, 0, 1); PG8_STAGE(PG8_SB(0, 0), b2, voffB); PG8_STAGE(PG8_SB(0, 1), b2 + hstep, voffB); PG8_STAGE(PG8_SA(0, 0), a2, w0); \
            PG8_WAIT_V(8); PG8_WAIT_L(0); PG8_BAR; PG8_MMAX(1, 0, At, B0, FIRST_); PG8_MMAX(1, 1, At, B1, FIRST_); PG8_BAR; PG8_SCHED; \
            PG8_LDB(B0, 1, 0); PG8_LDB(B1, 1, 1); PG8_SCHED; PG8_LDA(At, 1, 0); PG8_STAGE(PG8_SA(0, 1), a2, w1); \
            PG8_WAIT_V(8); PG8_WAIT_L(0); PG8_BAR; PG8_MMA(0, 0, At, B0); PG8_MMA(0, 1, At, B1); PG8_BAR; PG8_SCHED; \
            PG8_LDA(At, 1, 1); PG8_STAGE(PG8_SB(1, 0), b3, voffB); PG8_STAGE(PG8_SB(1, 1), b3 + hstep, voffB); PG8_STAGE(PG8_SA(1, 0), a3, w0); \
            PG8_WAIT_V(8); PG8_WAIT_L(0); PG8_BAR; PG8_MMA(1, 0, At, B0); PG8_MMA(1, 1, At, B1); PG8_BAR; PG8_SCHED; \
        } while (0)
        if constexpr (AB::FP8) { PG8_KITER(0, 1);
            for (int t = 2; t < nt; t += 2) PG8_KITER(t, 0);
        } else {
            {
#pragma unroll
                for (int a = 0; a < 2; ++a)
#pragma unroll
                    for (int b = 0; b < 2; ++b)
#pragma unroll
                        for (int m = 0; m < 4; ++m)
#pragma unroll
                            for (int n = 0; n < 2; ++n) acc[a][b][m][n] = (f32x4){0.f, 0.f, 0.f, 0.f}; }
            for (int t = 0; t < nt; t += 2) PG8_KITER(t, 0);
        }
#undef PG8_KITER
        GP_TS(gk1_);
        if constexpr (ALIGN_EPI) { if (wr == 0) PG8_BAR; }
        if constexpr (AB::FP8) asm volatile("s_nop 15\n\ts_nop 15\n\ts_nop 15" ::: "memory");
        GP_TS(gk1b_);
        if constexpr (!Epi::AFTER_DRAIN) { if constexpr (Epi::PREFETCH) E(acc, cur, wr, wc, fr, fq, lds + EPB_OFF + (ui & 1) * 2048); else E(acc, cur, wr, wc, fr, fq); }
        GP_TS(gk2_); GP_ACC();
        if (!has_next) break;
        cur = nxt; cA = nA; cB = nB; ++ui;
        if constexpr (AB::GATHER) {
#pragma unroll
            for (int i = 0; i < 2; ++i) { vA0[i] = g.off_from_tok(tk[i], cA_[i]); vA1[i] = g.off_from_tok(tk[2 + i], cA_[i]); }
        }
        if constexpr (ALIGN_EPI) { if (wr == 1) PG8_BAR; }
    }
    PG8_WAIT_V(0);
    if constexpr (!ALIGN_EPI) { if (wr == 0) PG8_BAR; }
    PG8_BAR;
    if constexpr (Epi::AFTER_DRAIN) { E.fused(acc, cur, wr, wc, fr, fq, lds, wid, lane); }
#undef GP_TS
#undef GP_ACC
#undef PG8_SA
#undef PG8_SB
#undef PG8_STAGE
#undef PG8_LDA
#undef PG8_LDB
#undef PG8_MMA
#undef PG8_MMAX
#undef PG8_WAIT_V
#undef PG8_WAIT_L
#undef PG8_BAR
#undef PG8_SCHED
}
}
namespace epi {
using pg8::Unit; using pg8::HALF; using pg8::BM;
typedef f32x4 Acc[2][2][4][2];

__device__ __forceinline__ u32x4 pack8(const f32x4& a, const f32x4& b) { u32x4 w; w.x = cvtpk(a[0], a[1]); w.y = cvtpk(a[2], a[3]); w.z = cvtpk(b[0], b[1]); w.w = cvtpk(b[2], b[3]); return w; }

__device__ __forceinline__ void store_plain(const Acc& acc, bf16_t* O, int ld, int col0, int row0, float sc) {
#pragma unroll
    for (int ai = 0; ai < 2; ++ai)
#pragma unroll
        for (int m = 0; m < 4; ++m) { bf16_t* rp = O + (size_t)(row0 + ai * HALF + m * 16) * ld + col0;
#pragma unroll
            for (int bj = 0; bj < 2; ++bj) *(u32x4*)(rp + bj * HALF) = pack8(acc[ai][bj][m][0] * sc, acc[ai][bj][m][1] * sc); }
}
struct EpiInProj {
    static constexpr bool PERM = true, AFTER_DRAIN = false, HOOKS = false, PREFETCH = true;
    bf16_t *Q, *Kk, *V, *UP, *QM, *G; const float *qn, *kn, *cs, *sn, *bg; int mode; float asc;
    __device__ __forceinline__ int ltile(const Unit& u) const { return (mode == 0) ? u.pn + 12 : (u.pn < 8 ? u.pn : (u.pn < 24 ? 16 + (u.pn - 8) : u.pn - 10)); }
    __device__ __forceinline__ void prefetch(const Unit& u, LAS unsigned char* eb, int wid, int lane) const {
        const int pn = ltile(u);
        if (wid == 0 && (pn < 8 || pn >= 16)) { int l_ = lane; asm volatile("" : "+v"(l_));
            const int seg = l_ >> 4, li = (l_ & 15) * 4;
            const float* src = (pn < 8) ? ((pn < 4 ? qn : kn) + li) : (bg + (seg < 3 ? seg : 2) * DM + (pn - 16) * 64 + li);
            __builtin_amdgcn_global_load_lds((const unsigned*)src, (LAS unsigned*)eb, 16, 0, 0); }
    }
    __device__ __forceinline__ void operator()(const Acc& acc_in, const Unit& u, int wr, int wc, int fr, int fq, const LAS unsigned char* eb) const {
        const int pn = ltile(u);
        const int row0 = u.pm * BM + wr * 64 + fr;
        const Acc& acc = acc_in;
        if (pn < 8) {
            const bool isq = pn < 4; bf16_t* O = isq ? Q : Kk; const float* gn = isq ? qn : kn; const float sc = isq ? C2 : 1.0f;
            const int ct = (isq ? pn : pn - 4) * 256 + wc * 64 + 8 * fq;
            f32x4 g[2][2];
#pragma unroll
            for (int bj = 0; bj < 2; ++bj)
#pragma unroll
                for (int n = 0; n < 2; ++n) g[bj][n] = *(const LAS f32x4*)(eb + (32 * bj + 8 * fq + 4 * n) * 4);
#pragma unroll
            for (int ai = 0; ai < 2; ++ai)
#pragma unroll
                for (int m = 0; m < 4; ++m) {
                    const int row = row0 + ai * HALF + m * 16; const int pos = row & (SEQ - 1);
                    float ss = 0.f;
#pragma unroll
                    for (int bj = 0; bj < 2; ++bj)
#pragma unroll
                        for (int n = 0; n < 2; ++n) { const f32x4 x = acc[ai][bj][m][n]; ss += (x[0] * x[0] + x[1] * x[1]) + (x[2] * x[2] + x[3] * x[3]); }
                    ss += __shfl_xor(ss, 16); ss += __shfl_xor(ss, 32);
                    const float rstd = __builtin_amdgcn_rsqf(ss * (asc * asc * (1.0f / 64.0f)) + EPS) * (sc * asc);
                    f32x4 o1[2], o2[2];
#pragma unroll
                    for (int n = 0; n < 2; ++n) {
                        const f32x4 c = *(const f32x4*)(cs + pos * 32 + 8 * fq + 4 * n), s = *(const f32x4*)(sn + pos * 32 + 8 * fq + 4 * n);
                        const f32x4 t1 = acc[ai][0][m][n] * rstd * g[0][n], t2 = acc[ai][1][m][n] * rstd * g[1][n];
                        o1[n] = t1 * c - t2 * s; o2[n] = t2 * c + t1 * s;
                    }
                    bf16_t* rp = O + (size_t)row * DM + ct;
                    *(u32x4*)(rp) = pack8(o1[0], o1[1]); *(u32x4*)(rp + 32) = pack8(o2[0], o2[1]);
                }
        } else if (pn < 14) { store_plain(acc, UP, 512, (pn - 12) * 256 + wc * 32 + 8 * fq, row0, asc);
        } else if (pn < 16) { store_plain(acc, QM, 512, (pn - 14) * 256 + wc * 32 + 8 * fq, row0, asc);
        } else {
            const int ch0 = (pn - 16) * 64 + wc * 16 + 4 * fq;
            const int cl4 = (wc * 16 + 4 * fq) * 4;
            const f32x4 ba = *(const LAS f32x4*)(eb + cl4) * (-LOG2E), bb = *(const LAS f32x4*)(eb + 256 + cl4) * (-LOG2E), bm = *(const LAS f32x4*)(eb + 512 + cl4) * (-LOG2E);
            const float sce = -LOG2E * asc;
            u32x2 wprev[4];
#pragma unroll
            for (int ai = 0; ai < 2; ++ai)
#pragma unroll
                for (int m = 0; m < 4; ++m) { const size_t row = (size_t)(row0 + ai * HALF + m * 16);
                    f32x4 r1, r2, g3;
#pragma unroll
                    for (int e = 0; e < 4; ++e) {
                        const float da = 1.0f + __builtin_amdgcn_exp2f(fminf(fmaf(acc[ai][0][m][0][e], sce, ba[e]), 64.0f));
                        const float db = 1.0f + __builtin_amdgcn_exp2f(fminf(fmaf(acc[ai][0][m][1][e], sce, bb[e]), 64.0f));
                        const float dm = 1.0f + __builtin_amdgcn_exp2f(fminf(fmaf(acc[ai][1][m][0][e], sce, bm[e]), 64.0f));
                        const float im = __builtin_amdgcn_rcpf(dm);
                        r1[e] = db * __builtin_amdgcn_rcpf(da); r2[e] = dm * __builtin_amdgcn_rcpf(db); g3[e] = im; }
                    const f32x4 vv = acc[ai][1][m][1] * asc;
                    u32x2 w[4];
                    w[0].x = cvtpk(r1[0], r1[1]); w[0].y = cvtpk(r1[2], r1[3]); w[1].x = cvtpk(r2[0], r2[1]); w[1].y = cvtpk(r2[2], r2[3]);
                    w[2].x = cvtpk(g3[0], g3[1]); w[2].y = cvtpk(g3[2], g3[3]); w[3].x = cvtpk(vv[0], vv[1]); w[3].y = cvtpk(vv[2], vv[3]);
                    if ((m & 1) == 0) {
#pragma unroll
                        for (int k = 0; k < 4; ++k) wprev[k] = w[k];
                    } else {
                        int od = fq & 1; asm volatile("" : "+v"(od));
                        const size_t rowx = row - 16 + 16 * od; const int chx = ch0 - 4 * od;
#pragma unroll
                        for (int k = 0; k < 4; ++k) {
                            const auto s0 = __builtin_amdgcn_permlane16_swap(wprev[k].x, w[k].x, false, false), s1 = __builtin_amdgcn_permlane16_swap(wprev[k].y, w[k].y, false, false);
                            u32x4 o; o.x = s0[0]; o.y = s1[0]; o.z = s0[1]; o.w = s1[1];
                            if (k < 3) *(u32x4*)(G + rowx * 3072 + k * DM + chx) = o; else *(u32x4*)(V + rowx * DM + chx) = o; } } }
        }
    }
};

struct EpiMemKV {
    static constexpr bool PERM = true, AFTER_DRAIN = true, HOOKS = false, PREFETCH = false;
    bf16_t *KM, *VM; const float *mk, *mq;
    __device__ __forceinline__ void fused(const Acc& acc, const Unit& u, int wr, int wc, int fr, int fq, LAS unsigned char* lds, int wid, int lane) const {
        const int pn = u.pn;
        if (pn < 2) {
            LAS float* P = (LAS float*)lds;
#pragma unroll
            for (int ai = 0; ai < 2; ++ai)
#pragma unroll
                for (int m = 0; m < 4; ++m)
#pragma unroll
                    for (int bj = 0; bj < 2; ++bj) {
                        float ss = 0.f;
#pragma unroll
                        for (int n = 0; n < 2; ++n) { const f32x4 x = acc[ai][bj][m][n]; ss += (x[0] * x[0] + x[1] * x[1]) + (x[2] * x[2] + x[3] * x[3]); }
                        ss += __shfl_xor(ss, 16); ss += __shfl_xor(ss, 32);
                        if (fq == 0) P[((ai * HALF + wr * 64 + m * 16 + fr) * 2 + bj) * 4 + wc] = ss;
                    }
            WG_BAR();
            const int d0 = wc * 32 + 8 * fq;
            f32x4 gn[2];
#pragma unroll
            for (int n = 0; n < 2; ++n) { const f32x4 a = *(const f32x4*)(mk + d0 + 4 * n), b = *(const f32x4*)(mq + d0 + 4 * n); gn[n] = a * b * C3; }
#pragma unroll
            for (int ai = 0; ai < 2; ++ai)
#pragma unroll
                for (int m = 0; m < 4; ++m) { const int rl = ai * HALF + wr * 64 + m * 16 + fr;
#pragma unroll
                    for (int bj = 0; bj < 2; ++bj) {
                        const f32x4 p4 = *(const LAS f32x4*)(P + (rl * 2 + bj) * 4);
                        const float rstd = __builtin_amdgcn_rsqf(((p4[0] + p4[1]) + (p4[2] + p4[3])) * (1.0f / 128.0f) + EPS);
                        const f32x4 a = acc[ai][bj][m][0] * rstd * gn[0], b = acc[ai][bj][m][1] * rstd * gn[1];
                        *(u32x4*)(KM + (size_t)(u.pm * BM + rl) * 512 + (2 * pn + bj) * 128 + d0) = pack8(a, b);
                    } }
        } else {
            const int col0 = (pn - 2) * 256 + wc * 32 + 8 * fq;
#pragma unroll
            for (int ai = 0; ai < 2; ++ai)
#pragma unroll
                for (int m = 0; m < 4; ++m) { bf16_t* rp = VM + (size_t)(u.pm * BM + ai * HALF + wr * 64 + m * 16 + fr) * 512 + col0;
#pragma unroll
                    for (int bj = 0; bj < 2; ++bj) *(u32x4*)(rp + bj * HALF) = pack8(acc[ai][bj][m][0], acc[ai][bj][m][1]); }
        }
    }
};

struct EpiMerge3 {
    static constexpr bool PERM = true, AFTER_DRAIN = false, HOOKS = true, PREFETCH = false; static constexpr int HOOK1 = 16, HOOK2 = 24;
    const bf16_t* G; bf16_t* M;
    __device__ __forceinline__ void hook(Acc& acc, const Unit& u, int t, int wr, int wc, int fr, int fq) const {
        int row0 = u.pm * BM + wr * 64 + fr; asm volatile("" : "+v"(row0));
        const int col0 = u.pn * BM + wc * 32 + 8 * fq; const int ga = (t == HOOK1) ? 0 : DM;
#pragma unroll
        for (int ai = 0; ai < 2; ++ai) {
            u32x4 na[8];
#pragma unroll
            for (int i = 0; i < 8; ++i) { const size_t row = (size_t)(row0 + ai * HALF + (i >> 1) * 16); na[i] = *(const u32x4*)(G + row * 3072 + ga + col0 + (i & 1) * HALF); }
#pragma unroll
            for (int i = 0; i < 8; ++i) { const int m = i >> 1, bj = i & 1;
                f32x4& a = acc[ai][bj][m][0]; f32x4& b = acc[ai][bj][m][1];
                a[0] *= bf_lo(na[i].x); a[1] *= bf_hi(na[i].x); a[2] *= bf_lo(na[i].y); a[3] *= bf_hi(na[i].y);
                b[0] *= bf_lo(na[i].z); b[1] *= bf_hi(na[i].z); b[2] *= bf_lo(na[i].w); b[3] *= bf_hi(na[i].w); }
            asm volatile("" ::: "memory"); }
    }
    __device__ __forceinline__ void operator()(const Acc& acc, const Unit& u, int wr, int wc, int fr, int fq) const {
        const int row0 = u.pm * BM + wr * 64 + fr, col0 = u.pn * BM + wc * 32 + 8 * fq;
#pragma unroll
        for (int ai = 0; ai < 2; ++ai)
#pragma unroll
            for (int m = 0; m < 4; ++m) { const size_t row = (size_t)(row0 + ai * HALF + m * 16);
#pragma unroll
                for (int bj = 0; bj < 2; ++bj) {
                    const u32x4 gw = *(const u32x4*)(G + row * 3072 + 2 * DM + col0 + bj * HALF);
                    f32x4 a = acc[ai][bj][m][0], b = acc[ai][bj][m][1];
                    a[0] *= bf_lo(gw.x); a[1] *= bf_hi(gw.x); a[2] *= bf_lo(gw.y); a[3] *= bf_hi(gw.y);
                    b[0] *= bf_lo(gw.z); b[1] *= bf_hi(gw.z); b[2] *= bf_lo(gw.w); b[3] *= bf_hi(gw.w);
                    *(u32x4*)(M + row * DM + col0 + bj * HALF) = pack8(a, b);
                } }
    }
};

struct EpiOut {
    static constexpr bool PERM = true, AFTER_DRAIN = false, HOOKS = false, PREFETCH = false;
    const float* X; bf16_t* HB; unsigned char* HB8;
    __device__ __forceinline__ void operator()(const Acc& acc, const Unit& u, int wr, int wc, int fr, int fq) const {
        const int row0 = u.pm * BM + wr * 64 + fr, col0 = u.pn * BM + wc * 32 + 8 * fq;
        constexpr int EPI_D = 6;
        f32x4 xa[EPI_D][2];
#define EPIOUT_OFF(it) ((size_t)(row0 + ((it) >> 3) * HALF + (((it) >> 1) & 3) * 16) * DM + col0 + ((it) & 1) * HALF)
#pragma unroll
        for (int it = 0; it < EPI_D; ++it) { xa[it][0] = *(const f32x4*)(X + EPIOUT_OFF(it)); xa[it][1] = *(const f32x4*)(X + EPIOUT_OFF(it) + 4); }
        __builtin_amdgcn_sched_barrier(0);
#pragma unroll
        for (int it = 0; it < 16; ++it) { const int ai = it >> 3, m = (it >> 1) & 3, bj = it & 1; const size_t off = EPIOUT_OFF(it);
            const f32x4 a = acc[ai][bj][m][0] + xa[it % EPI_D][0], b = acc[ai][bj][m][1] + xa[it % EPI_D][1];
            if (it + EPI_D < 16) { xa[it % EPI_D][0] = *(const f32x4*)(X + EPIOUT_OFF(it + EPI_D)); xa[it % EPI_D][1] = *(const f32x4*)(X + EPIOUT_OFF(it + EPI_D) + 4); }
            *(u32x4*)(HB + off) = pack8(a, b);
            u32x2 q; q.x = cvt4_fp8(clamp_fp8(a[0]), clamp_fp8(a[1]), clamp_fp8(a[2]), clamp_fp8(a[3])); q.y = cvt4_fp8(clamp_fp8(b[0]), clamp_fp8(b[1]), clamp_fp8(b[2]), clamp_fp8(b[3])); *(u32x2*)(HB8 + off) = q;
            __builtin_amdgcn_sched_barrier(0); }
#undef EPIOUT_OFF
    }
};

struct EpiGateUp {
    static constexpr bool PERM = true, AFTER_DRAIN = false, HOOKS = false, PREFETCH = true;
    const float* rslot; const float *bgate, *bup; unsigned char* ACT;
    __device__ __forceinline__ void prefetch(const Unit& u, LAS unsigned char* eb, int wid, int lane) const {
        if (wid < 2) { int l_ = lane; asm volatile("" : "+v"(l_));
            if (wid == 0) { const float* src = (l_ < 32) ? bgate : bup; __builtin_amdgcn_global_load_lds((const unsigned*)(src + u.e * DM + u.pn * 128 + (l_ & 31) * 4), (LAS unsigned*)eb, 16, 0, 0); }
            else __builtin_amdgcn_global_load_lds((const unsigned*)(rslot + (size_t)u.e * CAP + u.rb * 256 + l_ * 4), (LAS unsigned*)(eb + 1024), 16, 0, 0); }
    }
    __device__ __forceinline__ void operator()(const Acc& acc, const Unit& u, int wr, int wc, int fr, int fq, const LAS unsigned char* eb) const {
        const int cole = u.pn * 128 + wc * 32 + 8 * fq;
        f32x4 bgv[2], buv[2];
#pragma unroll
        for (int n = 0; n < 2; ++n) { bgv[n] = *(const LAS f32x4*)(eb + (wc * 32 + 8 * fq + 4 * n) * 4); buv[n] = *(const LAS f32x4*)(eb + 512 + (wc * 32 + 8 * fq + 4 * n) * 4) * ACT_SCALE + ACT_SCALE; }
        int nv = u.nvalid; asm volatile("" : "+s"(nv));
        float rsv[8];
#pragma unroll
        for (int i = 0; i < 8; ++i) { const int rl = (i >> 2) * HALF + wr * 64 + (i & 3) * 16 + fr; const int sl = rl < nv ? rl : nv - 1; rsv[i] = *(const LAS float*)(eb + 1024 + sl * 4); }
#pragma unroll
        for (int ai = 0; ai < 2; ++ai)
#pragma unroll
            for (int m = 0; m < 4; ++m) {
                const int rl = ai * HALF + wr * 64 + m * 16 + fr;
                const float rs = rsv[ai * 4 + m] * (1.0f / W8_SCALE), rs4 = rs * ACT_SCALE;
                f32x4 o[2];
#pragma unroll
                for (int n = 0; n < 2; ++n)
#pragma unroll
                    for (int e = 0; e < 4; e += 2) {
                        const f32x2 ag = {acc[ai][0][m][n][e], acc[ai][0][m][n][e + 1]}, au = {acc[ai][1][m][n][e], acc[ai][1][m][n][e + 1]};
                        const f32x2 bg2 = {bgv[n][e], bgv[n][e + 1]}, bu2 = {buv[n][e], buv[n][e + 1]};
                        f32x2 g = ag * rs + bg2; g.x = fminf(g.x, 7.0f); g.y = fminf(g.y, 7.0f);
                        f32x2 up = au * rs4 + bu2; up.x = __builtin_amdgcn_fmed3f(up.x, -6.0f * ACT_SCALE, 8.0f * ACT_SCALE); up.y = __builtin_amdgcn_fmed3f(up.y, -6.0f * ACT_SCALE, 8.0f * ACT_SCALE);
                        const f32x2 xe = g * (-1.702f * LOG2E); f32x2 d; d.x = __builtin_amdgcn_exp2f(xe.x); d.y = __builtin_amdgcn_exp2f(xe.y); d = d + 1.0f;
                        f32x2 r; r.x = __builtin_amdgcn_rcpf(d.x); r.y = __builtin_amdgcn_rcpf(d.y);
                        const f32x2 a2 = (g * up) * r; o[n][e] = a2.x; o[n][e + 1] = a2.y;
                    }
                u32x2 q; q.x = cvt4_fp8(o[0][0], o[0][1], o[0][2], o[0][3]); q.y = cvt4_fp8(o[1][0], o[1][1], o[1][2], o[1][3]);
                *(u32x2*)(ACT + (size_t)(u.pm * BM + rl) * DM + cole) = q;
            }
    }
};

struct EpiDown {
    static constexpr bool PERM = true, AFTER_DRAIN = false, HOOKS = false, PREFETCH = true;
    const float* bdown; unsigned char* OS;
    __device__ __forceinline__ void prefetch(const Unit& u, LAS unsigned char* eb, int wid, int lane) const {
        if (wid == 0) { int l_ = lane; asm volatile("" : "+v"(l_));
            __builtin_amdgcn_global_load_lds((const unsigned*)(bdown + u.e * DM + u.pn * BM + l_ * 4), (LAS unsigned*)eb, 16, 0, 0); }
    }
    __device__ __forceinline__ void operator()(const Acc& acc, const Unit& u, int wr, int wc, int fr, int fq, const LAS unsigned char* eb) const {
        const int col0 = u.pn * BM + wc * 32 + 8 * fq;
        f32x4 bv[2][2];
#pragma unroll
        for (int bj = 0; bj < 2; ++bj)
#pragma unroll
            for (int n = 0; n < 2; ++n) bv[bj][n] = *(const LAS f32x4*)(eb + (bj * HALF + wc * 32 + 8 * fq + 4 * n) * 4) * OS_SCALE;
        const int odd = fq & 1; const int colx = u.pn * BM + wc * 32 + 8 * (fq & 2);
#pragma unroll
        for (int ai = 0; ai < 2; ++ai)
#pragma unroll
            for (int mp = 0; mp < 4; mp += 2) { unsigned char* rp = OS + (size_t)(u.pm * BM + ai * HALF + wr * 64 + (mp + odd) * 16 + fr) * DM + colx;
#pragma unroll
                for (int bj = 0; bj < 2; ++bj) { u32x2 q[2];
#pragma unroll
                    for (int k = 0; k < 2; ++k) { const int m = mp + k;
                        const f32x4 a = acc[ai][bj][m][0] * (OS_SCALE / (W8_SCALE * ACT_SCALE)) + bv[bj][0], b = acc[ai][bj][m][1] * (OS_SCALE / (W8_SCALE * ACT_SCALE)) + bv[bj][1];
                        q[k].x = cvt4_fp8(clamp_fp8(a[0]), clamp_fp8(a[1]), clamp_fp8(a[2]), clamp_fp8(a[3])); q[k].y = cvt4_fp8(clamp_fp8(b[0]), clamp_fp8(b[1]), clamp_fp8(b[2]), clamp_fp8(b[3])); }
                    const auto s0 = __builtin_amdgcn_permlane16_swap(q[0].x, q[1].x, false, false), s1 = __builtin_amdgcn_permlane16_swap(q[0].y, q[1].y, false, false);
                    u32x4 w; w.x = s0[0]; w.y = s1[0]; w.z = s0[1]; w.w = s1[1];
                    *(u32x4*)(rp + bj * HALF) = w; } }
    }
};
}

namespace pg8 {
struct ABMoeGU {
    static constexpr bool GATHER = true, FP8 = true;
    const bf16_t* A; const bf16_t* Bt; const unsigned* list; int K;
    __device__ __forceinline__ const char* a_base(const Unit&) const { return (const char*)A; }
    __device__ __forceinline__ const char* b_base(const Unit& u) const { return (const char*)Bt + ((size_t)u.e * 2048 + (size_t)u.pn * BM) * K * 2; }
    __device__ __forceinline__ const unsigned* tok_ptr(const Unit& u, int r) const { const int sl = r < u.nvalid ? r : u.nvalid - 1; return list + (size_t)u.e * CAP + u.rb * 256 + sl; }
    __device__ __forceinline__ unsigned off_from_tok(unsigned tok, int c) const { return (tok * (unsigned)K + (unsigned)c) * 2u; }
    __device__ __forceinline__ unsigned a_off(const Unit& u, int r, int c) const { return off_from_tok(*tok_ptr(u, r), c); }
};
struct ABMoeDown {
    static constexpr bool GATHER = false, FP8 = true;
    const bf16_t* A; const bf16_t* Bt; int K;
    __device__ __forceinline__ const char* a_base(const Unit& u) const { return (const char*)A + (size_t)u.pm * BM * K * 2; }
    __device__ __forceinline__ const char* b_base(const Unit& u) const { return (const char*)Bt + ((size_t)u.e * DM + (size_t)u.pn * BM) * K * 2; }
    __device__ __forceinline__ unsigned a_off(const Unit&, int r, int c) const { return (unsigned)(r * K + c) * 2u; }
};
struct MoeOrder {
    const volatile LAS int* cnt; const volatile LAS int* cum; const volatile LAS int* rb2e; int nN, G, c, total;
    __device__ __forceinline__ bool next(int i, Unit& u) const {
        const long L = (long)i * G + c; if (L >= total) return false;
        const int rbg = (int)(L / nN); u.pn = (int)(L % nN);
        const int e = __builtin_amdgcn_readfirstlane(rb2e[rbg]);
        u.e = e; u.rb = rbg - __builtin_amdgcn_readfirstlane(cum[e]); u.pm = rbg; const int left = __builtin_amdgcn_readfirstlane(cnt[e]) - u.rb * 256; u.nvalid = left < 256 ? left : 256; return true;
    }
};
}
namespace att {
#define MFMA32(a, b, c) __builtin_amdgcn_mfma_f32_32x32x16_bf16((a), (b), (c), 0, 0, 0)
__device__ __forceinline__ int crow(int r, int hi) { return (r & 3) + 8 * (r >> 2) + 4 * hi; }
typedef short v4i16_t __attribute__((ext_vector_type(4)));
__device__ __forceinline__ s16x4 vtr(const LAS char* p) { return __builtin_bit_cast(s16x4, __builtin_amdgcn_ds_read_tr16_b64_v4i16((LAS v4i16_t*)p)); }

template <int ND0> __device__ __forceinline__ void qk_tile(f32x16& p0, f32x16& p1, const LAS char* kb, const bf16x8* qr) {
    f32x16 z = {0.f, 0.f, 0.f, 0.f, 0.f, 0.f, 0.f, 0.f, 0.f, 0.f, 0.f, 0.f, 0.f, 0.f, 0.f, 0.f};
    p0 = z; p1 = z;
#pragma unroll
    for (int d0 = 0; d0 < ND0; ++d0) {
        const bf16x8 b0 = *(const LAS bf16x8*)(kb + d0 * 2048), b1 = *(const LAS bf16x8*)(kb + d0 * 2048 + 512);
        p0 = MFMA32(b0, qr[d0], p0); p1 = MFMA32(b1, qr[d0], p1);
    }
}
__device__ __forceinline__ void softmax_pv(f32x16& p0, f32x16& p1, float& mrow, float& lrow, f32x16 (&o)[4], const LAS char* vp, LAS float* wsf, int r32, int hi) {
    float a = fmaxf(p0[0], p1[0]);
#pragma unroll
    for (int r = 1; r < 16; ++r) a = fmaxf(a, fmaxf(p0[r], p1[r]));
    { auto rr = __builtin_amdgcn_permlane32_swap(__float_as_uint(a), __float_as_uint(a), false, false); a = fmaxf(__uint_as_float(rr[0]), __uint_as_float(rr[1])); }
    const float mnew = fmaxf(mrow, a);
    if (__any(mnew > mrow)) {
        const float f = __builtin_amdgcn_exp2f(mrow - mnew);
        lrow *= f;
        if (hi == 0) wsf[r32] = f;
        LDS_WAIT();
#pragma unroll
        for (int g = 0; g < 4; ++g) { const f32x4 f4 = *(const LAS f32x4*)(wsf + 8 * g + 4 * hi);
#pragma unroll
            for (int d = 0; d < 4; ++d) { o[d][4 * g + 0] *= f4[0]; o[d][4 * g + 1] *= f4[1]; o[d][4 * g + 2] *= f4[2]; o[d][4 * g + 3] *= f4[3]; } }
        mrow = mnew;
    }
    float s = 0.f;
#pragma unroll
    for (int r = 0; r < 16; ++r) { p0[r] = __builtin_amdgcn_exp2f(p0[r] - mrow); p1[r] = __builtin_amdgcn_exp2f(p1[r] - mrow); s += p0[r] + p1[r]; }
    lrow += s;
    bf16x8 pa[4];
    { u32x4 w;
      w.x = cvtpk(p0[0], p0[1]); w.y = cvtpk(p0[2], p0[3]); w.z = cvtpk(p0[4], p0[5]); w.w = cvtpk(p0[6], p0[7]); pa[0] = __builtin_bit_cast(bf16x8, w);
      w.x = cvtpk(p0[8], p0[9]); w.y = cvtpk(p0[10], p0[11]); w.z = cvtpk(p0[12], p0[13]); w.w = cvtpk(p0[14], p0[15]); pa[1] = __builtin_bit_cast(bf16x8, w);
      w.x = cvtpk(p1[0], p1[1]); w.y = cvtpk(p1[2], p1[3]); w.z = cvtpk(p1[4], p1[5]); w.w = cvtpk(p1[6], p1[7]); pa[2] = __builtin_bit_cast(bf16x8, w);
      w.x = cvtpk(p1[8], p1[9]); w.y = cvtpk(p1[10], p1[11]); w.z = cvtpk(p1[12], p1[13]); w.w = cvtpk(p1[14], p1[15]); pa[3] = __builtin_bit_cast(bf16x8, w); }
#pragma unroll
    for (int d = 0; d < 4; ++d)
#pragma unroll
        for (int ks = 0; ks < 4; ++ks) {
            const s16x4 lo = vtr(vp + d * 4096 + ks * 1024), hh = vtr(vp + d * 4096 + ks * 1024 + 512);
            const bf16x8 vf = (bf16x8){lo[0], lo[1], lo[2], lo[3], hh[0], hh[1], hh[2], hh[3]};
            o[d] = MFMA32(pa[ks], vf, o[d]);
        }
}

constexpr int DA_KOFF = 0, DA_VOFF = 65536, DA_BUF = 16384;
#define DA_THR 8.0f
#define FMAX3(a, b, c) __builtin_fmaxf(__builtin_fmaxf((a), (b)), (c))
__device__ __forceinline__ float rowmax32(const f32x16& a, const f32x16& b) {
    float m0 = FMAX3(a[0], a[1], b[0]), m1 = FMAX3(a[2], a[3], b[1]); m0 = FMAX3(m0, b[2], b[3]);
#pragma unroll
    for (int r = 4; r < 16; r += 4) { m0 = FMAX3(m0, a[r], a[r + 1]); m1 = FMAX3(m1, a[r + 2], a[r + 3]); m0 = FMAX3(m0, b[r], b[r + 1]); m1 = FMAX3(m1, b[r + 2], b[r + 3]); }
    float m = __builtin_fmaxf(m0, m1);
    auto rr = __builtin_amdgcn_permlane32_swap(__float_as_uint(m), __float_as_uint(m), false, false);
    return __builtin_fmaxf(__uint_as_float(rr[0]), __uint_as_float(rr[1]));
}
__device__ __forceinline__ void da_unit(const int tid_in, int b, int h, int qb, const bf16_t* Q, const bf16_t* Kg, const bf16_t* Vg, bf16_t* O, int ldo, float lam, const float* gsub, LAS unsigned char* lds, int rot = 0) {
    int tid = tid_in; asm volatile("" : "+v"(tid));
#if DA_PROF
    const unsigned tu0_ = (unsigned)__builtin_amdgcn_s_memrealtime();
#endif
    const int lane = tid & 63, r32 = lane & 31, hi = lane >> 5; const int wid = __builtin_amdgcn_readfirstlane(tid >> 6);
    const int comp = wid >> 2, w4 = wid & 3;
    const size_t rowbase = (size_t)b * SEQ;
    LAS float* wsf = (LAS float*)(lds + WSF_OFF) + wid * 64;
    bf16x8 qreg[4];
    { const bf16_t* Qw = Q + (rowbase + qb * 128 + w4 * 32 + r32) * DM + h * 128 + comp * 64 + hi * 8;
#pragma unroll
      for (int d0 = 0; d0 < 4; ++d0) qreg[d0] = *(const bf16x8*)(Qw + d0 * 16); }
#define qr_(d0) qreg[d0]
    const int NT = 2 * qb + 2;
    const int NI = NT - 2, rsh = (rot * NI) >> 4;
#define DA_TM(t) (((t) < NI) ? (((t) + rsh >= NI) ? (t) + rsh - NI : (t) + rsh) : (t))
    unsigned ksrc[2], vsrc[2], kdst[2], vdst[2];
#pragma unroll
    for (int j = 0; j < 2; ++j) { const int p = wid * 2 + j;
        ksrc[j] = (unsigned)(((rowbase + 16 * ((p >> 1) & 3) + (lane >> 2)) * DM + h * 128 + (p >> 3) * 64 + (p & 1) * 32 + (((lane & 3) ^ ((lane >> 4) & 3)) * 8)) * 2); kdst[j] = DA_KOFF + p * 1024;
        vsrc[j] = (unsigned)(((rowbase + 16 * (p & 3) + (lane >> 2)) * DM + h * 128 + (p >> 2) * 32 + (lane & 3) * 8) * 2); vdst[j] = DA_VOFF + p * 1024; }
#define DA_DMA_K(t, soff) do { _Pragma("unroll") for (int j_ = 0; j_ < 2; ++j_) \
        __builtin_amdgcn_global_load_lds((const unsigned*)((const char*)Kg + (size_t)(ksrc[j_] + (unsigned)DA_TM(t) * (64u * DM * 2u))), (LAS unsigned*)(lds + kdst[j_] + (soff)), 16, 0, 0); } while (0)
#define DA_DMA_V(t, soff) do { _Pragma("unroll") for (int j_ = 0; j_ < 2; ++j_) \
        __builtin_amdgcn_global_load_lds((const unsigned*)((const char*)Vg + (size_t)(vsrc[j_] + (unsigned)DA_TM(t) * (64u * DM * 2u))), (LAS unsigned*)(lds + vdst[j_] + (soff)), 16, 0, 0); } while (0)
    float mref = 0.f, lrow = 0.f; f32x16 o[4], negm;
#pragma unroll
    for (int r = 0; r < 16; ++r) { negm[r] = 0.f;
#pragma unroll
        for (int d = 0; d < 4; ++d) o[d][r] = 0.f; }
    const LAS char* ldc = (const LAS char*)lds;
    const LAS char* kbase = ldc + DA_KOFF + comp * 8192 + (r32 >> 4) * 2048 + (r32 & 15) * 64;
    const int kswz = (hi ^ ((r32 >> 2) & 3)) * 16;
    const LAS char* vbase = ldc + DA_VOFF + ((lane >> 4) & 1) * 32 + (lane & 3) * 8 + (4 * hi + ((lane & 15) >> 2)) * 64;
    const int qpos = qb * 128 + w4 * 32 + r32;
#define DA_KF(d0, half) (*(const LAS bf16x8*)(kb_ + ((d0) >> 1) * 1024 + (((d0) & 1) ? (kswz ^ 32) : kswz) + (half) * 4096))
#define DA_QK(P0, P1, soff) do { const LAS char* kb_ = kbase + (soff); \
        { const bf16x8 b0_ = DA_KF(0, 0), b1_ = DA_KF(0, 1); P0 = MFMA32(b0_, qr_(0), negm); P1 = MFMA32(b1_, qr_(0), negm); } \
        _Pragma("unroll") for (int d0_ = 1; d0_ < 4; ++d0_) { const bf16x8 b0_ = DA_KF(d0_, 0), b1_ = DA_KF(d0_, 1); \
            P0 = MFMA32(b0_, qr_(d0_), P0); P1 = MFMA32(b1_, qr_(d0_), P1); } } while (0)
#define DA_MASK(P0, P1, t) do { const int kb_ = 64 * (t) + 4 * hi; \
        _Pragma("unroll") for (int r = 0; r < 16; ++r) { const int kv_ = kb_ + (r & 3) + 8 * (r >> 2); if (kv_ > qpos) P0[r] = -__builtin_inff(); if (kv_ + 32 > qpos) P1[r] = -__builtin_inff(); } } while (0)
#define DA_MOVE_REF(P0, P1, dl) do { mref += (dl); \
        _Pragma("unroll") for (int r = 0; r < 16; ++r) { P0[r] -= (dl); P1[r] -= (dl); negm[r] = -mref; } \
        const float f_ = __builtin_amdgcn_exp2f(-(dl)); lrow *= f_; if (hi == 0) wsf[r32] = f_; LDS_WAIT(); \
        _Pragma("unroll") for (int g = 0; g < 4; ++g) { const f32x4 f4 = *(const LAS f32x4*)(wsf + 8 * g + 4 * hi); \
            _Pragma("unroll") for (int d = 0; d < 4; ++d) { o[d][4 * g + 0] *= f4[0]; o[d][4 * g + 1] *= f4[1]; o[d][4 * g + 2] *= f4[2]; o[d][4 * g + 3] *= f4[3]; } } } while (0)
#define DA_STEP(PC0, PC1, PN0, PN1, tt) do { const int t_ = (tt); \
        if (t_ + 4 < NT) DA_DMA_K(t_ + 4, sKf); \
        if (t_ + 2 < NT) DA_DMA_V(t_ + 2, sVf); \
        const bool actn_ = (t_ + 1 < NT) && !((t_ + 1 == NT - 1) && w4 < 2), actc_ = !((t_ == NT - 1) && w4 < 2); \
        if (actn_) { DA_QK(PN0, PN1, sKc); if (t_ + 1 >= NT - 2) DA_MASK(PN0, PN1, t_ + 1); } \
        if (actc_) { float s_ = 0.f; \
            _Pragma("unroll") for (int r = 0; r < 16; ++r) { PC0[r] = __builtin_amdgcn_exp2f(PC0[r]); PC1[r] = __builtin_amdgcn_exp2f(PC1[r]); s_ += PC0[r]; s_ += PC1[r]; } \
            lrow += s_; \
            bf16x8 pa_[4]; { u32x4 w_; \
              w_.x = cvtpk(PC0[0], PC0[1]); w_.y = cvtpk(PC0[2], PC0[3]); w_.z = cvtpk(PC0[4], PC0[5]); w_.w = cvtpk(PC0[6], PC0[7]); pa_[0] = __builtin_bit_cast(bf16x8, w_); \
              w_.x = cvtpk(PC0[8], PC0[9]); w_.y = cvtpk(PC0[10], PC0[11]); w_.z = cvtpk(PC0[12], PC0[13]); w_.w = cvtpk(PC0[14], PC0[15]); pa_[1] = __builtin_bit_cast(bf16x8, w_); \
              w_.x = cvtpk(PC1[0], PC1[1]); w_.y = cvtpk(PC1[2], PC1[3]); w_.z = cvtpk(PC1[4], PC1[5]); w_.w = cvtpk(PC1[6], PC1[7]); pa_[2] = __builtin_bit_cast(bf16x8, w_); \
              w_.x = cvtpk(PC1[8], PC1[9]); w_.y = cvtpk(PC1[10], PC1[11]); w_.z = cvtpk(PC1[12], PC1[13]); w_.w = cvtpk(PC1[14], PC1[15]); pa_[3] = __builtin_bit_cast(bf16x8, w_); } \
            const LAS char* vp_ = vbase + sVc; \
            _Pragma("unroll") for (int d = 0; d < 4; ++d) _Pragma("unroll") for (int ks = 0; ks < 4; ++ks) { \
                const s16x4 lo_ = vtr(vp_ + d * 4096 + ks * 1024), hh_ = vtr(vp_ + d * 4096 + ks * 1024 + 512); \
                const bf16x8 vf_ = (bf16x8){lo_[0], lo_[1], lo_[2], lo_[3], hh_[0], hh_[1], hh_[2], hh_[3]}; \
                o[d] = MFMA32(pa_[ks], vf_, o[d]); } } \
        if (actn_) { const float rm_ = rowmax32(PN0, PN1); \
            if (__any(rm_ > DA_THR)) { const float dl_ = __builtin_fmaxf(rm_, 0.f); DA_MOVE_REF(PN0, PN1, dl_); } } \
        { const unsigned x_ = sKf; sKf = sKc; sKc = sKn; sKn = sKm; sKm = x_; const unsigned y_ = sVf; sVf = sVc; sVc = sVn; sVn = y_; } \
        WG_BAR(); } while (0)

#define DA_PIN(x) asm volatile("" : "+v"(x))
#ifndef DA_PROF
#define DA_PROF 0
#endif
#if DA_PROF
#define DA_T(v) const unsigned v = (unsigned)__builtin_amdgcn_s_memrealtime(); __builtin_amdgcn_sched_barrier(0)
#define DA_PROF_ACC() do { if (wid == 0 && lane == 0) { volatile LAS unsigned* pf_ = (volatile LAS unsigned*)(lds + MISC_OFF) + 3300; \
        pf_[0] += t0_ - tm_; pf_[1] += t1_ - t0_; pf_[2] += t2_ - t1_; pf_[3] += t3_ - t2_; pf_[4] += t4_ - t3_; pf_[5] += t5_ - t4_; pf_[6] += 1u; } } while (0)
#else
#define DA_T(v)
#define DA_PROF_ACC() do { } while (0)
#endif
#define DA_GAP() __builtin_amdgcn_sched_barrier(0)
#define DA_VF(i) ({ const s16x4 lo_ = vtr(vp_ + ((i) & 3) * 4096 + ((i) >> 2) * 1024), hh_ = vtr(vp_ + ((i) & 3) * 4096 + ((i) >> 2) * 1024 + 512); (bf16x8){lo_[0], lo_[1], lo_[2], lo_[3], hh_[0], hh_[1], hh_[2], hh_[3]}; })
#define DA_EXP8(P, B) do { _Pragma("unroll") for (int r_ = 0; r_ < 8; ++r_) P[(B) + r_] = __builtin_amdgcn_exp2f(P[(B) + r_]); DA_PIN(P); } while (0)
#define DA_PVGAP(i, PA, PKSTMT) do { o[(i) & 3] = MFMA32(PA, vf_[(i) % 3], o[(i) & 3]); if ((i) + 3 < 16) vf_[(i) % 3] = DA_VF((i) + 3); \
        sA_ += PCa[i]; sB_ += PCb[i]; DA_PIN(sA_); DA_PIN(sB_); PKSTMT; mx_ = FMAX3(mx_, PNa[i], PNb[i]); DA_PIN(mx_); DA_GAP(); } while (0)
#define DA_STEPX(PC0, PC1, PN0, PN1, tt) do { const int t_ = (tt); DA_T(tm_); \
        if (t_ + 4 < NT) DA_DMA_K(t_ + 4, sKf); DA_DMA_V(t_ + 2, sVf); DA_T(t0_); \
        const LAS char* kb_ = kbase + sKc; const LAS char* vp_ = vbase + sVc; bf16x8 vf_[3]; \
        PN0 = MFMA32(ka_, qa_, negm); PN1 = MFMA32(kb2_, qa_, negm); ka_ = DA_KF(2, 0); kb2_ = DA_KF(2, 1); qa_ = qr_(1); DA_EXP8(PC0, 0); DA_GAP(); \
        PN0 = MFMA32(kc_, qa_, PN0); PN1 = MFMA32(kd_, qa_, PN1); kc_ = DA_KF(3, 0); kd_ = DA_KF(3, 1); qa_ = qr_(2); DA_EXP8(PC0, 8); DA_GAP(); \
        PN0 = MFMA32(ka_, qa_, PN0); PN1 = MFMA32(kb2_, qa_, PN1); qa_ = qr_(3); vf_[0] = DA_VF(0); DA_EXP8(PC1, 0); DA_GAP(); \
        PN0 = MFMA32(kc_, qa_, PN0); PN1 = MFMA32(kd_, qa_, PN1); vf_[1] = DA_VF(1); vf_[2] = DA_VF(2); DA_EXP8(PC1, 8); DA_GAP(); \
        DA_T(t1_); if (t_ + 1 >= NT - 2) DA_MASK(PN0, PN1, t_ + 1); \
        u32x4 we_, wo_; float sA_ = 0.f, sB_ = 0.f, mx_ = -__builtin_inff(); \
        we_.x = cvtpk(PC0[0], PC0[1]); we_.y = cvtpk(PC0[2], PC0[3]); we_.z = cvtpk(PC0[4], PC0[5]); we_.w = cvtpk(PC0[6], PC0[7]); DA_GAP(); \
        { const f32x16& PCa = PC0; const f32x16& PCb = PC1; const f32x16& PNa = PN0; const f32x16& PNb = PN1; \
        DA_PVGAP(0, __builtin_bit_cast(bf16x8, we_), wo_.x = cvtpk(PC0[8], PC0[9]));   DA_PVGAP(1, __builtin_bit_cast(bf16x8, we_), wo_.y = cvtpk(PC0[10], PC0[11])); \
        DA_PVGAP(2, __builtin_bit_cast(bf16x8, we_), wo_.z = cvtpk(PC0[12], PC0[13])); DA_PVGAP(3, __builtin_bit_cast(bf16x8, we_), wo_.w = cvtpk(PC0[14], PC0[15])); \
        DA_PVGAP(4, __builtin_bit_cast(bf16x8, wo_), we_.x = cvtpk(PC1[0], PC1[1]));   DA_PVGAP(5, __builtin_bit_cast(bf16x8, wo_), we_.y = cvtpk(PC1[2], PC1[3])); \
        DA_PVGAP(6, __builtin_bit_cast(bf16x8, wo_), we_.z = cvtpk(PC1[4], PC1[5]));   DA_PVGAP(7, __builtin_bit_cast(bf16x8, wo_), we_.w = cvtpk(PC1[6], PC1[7])); \
        DA_PVGAP(8, __builtin_bit_cast(bf16x8, we_), wo_.x = cvtpk(PC1[8], PC1[9]));   DA_PVGAP(9, __builtin_bit_cast(bf16x8, we_), wo_.y = cvtpk(PC1[10], PC1[11])); \
        DA_PVGAP(10, __builtin_bit_cast(bf16x8, we_), wo_.z = cvtpk(PC1[12], PC1[13])); DA_PVGAP(11, __builtin_bit_cast(bf16x8, we_), wo_.w = cvtpk(PC1[14], PC1[15])); \
        DA_PVGAP(12, __builtin_bit_cast(bf16x8, wo_), (void)0); DA_PVGAP(13, __builtin_bit_cast(bf16x8, wo_), (void)0); DA_PVGAP(14, __builtin_bit_cast(bf16x8, wo_), (void)0); DA_PVGAP(15, __builtin_bit_cast(bf16x8, wo_), (void)0); } \
        DA_T(t2_); lrow += sA_ + sB_; \
        { kb_ = kbase + sKn; ka_ = DA_KF(0, 0); kb2_ = DA_KF(0, 1); kc_ = DA_KF(1, 0); kd_ = DA_KF(1, 1); qa_ = qr_(0); }                        \
        { auto rr_ = __builtin_amdgcn_permlane32_swap(__float_as_uint(mx_), __float_as_uint(mx_), false, false); mx_ = __builtin_fmaxf(__uint_as_float(rr_[0]), __uint_as_float(rr_[1])); } \
        if (__any(mx_ > DA_THR)) { const float dl_ = __builtin_fmaxf(mx_, 0.f); DA_MOVE_REF(PN0, PN1, dl_); } \
        { const unsigned x_ = sKf; sKf = sKc; sKc = sKn; sKn = sKm; sKm = x_; const unsigned y_ = sVf; sVf = sVc; sVc = sVn; sVn = y_; } \
        DA_T(t3_); \
        if (DA_PROF) { if (t_ + 4 < NT) asm volatile("s_waitcnt vmcnt(4) lgkmcnt(0)" ::: "memory"); else asm volatile("s_waitcnt vmcnt(2) lgkmcnt(0)" ::: "memory"); DA_T(t4_); asm volatile("s_barrier" ::: "memory"); DA_T(t5_); DA_PROF_ACC(); } \
        else if (t_ + 4 < NT) asm volatile("s_waitcnt vmcnt(4) lgkmcnt(0)\n\ts_barrier" ::: "memory");            \
        else asm volatile("s_waitcnt vmcnt(2) lgkmcnt(0)\n\ts_barrier" ::: "memory"); } while (0)

    f32x16 pA0, pA1, pB0, pB1;
#define DA_START() do { DA_DMA_K(0, 0); DA_DMA_V(0, 0); DA_DMA_K(1, DA_BUF); DA_DMA_V(1, DA_BUF); if (NT > 2) { DA_DMA_K(2, 2 * DA_BUF); DA_DMA_K(3, 3 * DA_BUF); } \
    WG_BAR(); \
    DA_QK(pA0, pA1, 0); \
    if (NT == 2) DA_MASK(pA0, pA1, 0); \
    { const float rm = rowmax32(pA0, pA1); mref = rm;                          \
      _Pragma("unroll") for (int r = 0; r < 16; ++r) { pA0[r] -= rm; pA1[r] -= rm; negm[r] = -mref; } } \
    WG_BAR(); } while (0)
    unsigned sKc = DA_BUF, sKn = 2 * DA_BUF, sKm = 3 * DA_BUF, sKf = 0;
    unsigned sVc = 0, sVn = DA_BUF, sVf = 2 * DA_BUF;
#if DA_PROF
    unsigned tS_ = 0, tI_ = 0;
#define DA_TS(v) do { v = (unsigned)__builtin_amdgcn_s_memrealtime(); __builtin_amdgcn_sched_barrier(0); } while (0)
#else
#define DA_TS(v) do { } while (0)
#endif
    if (NT == 2) {
        DA_START();
        DA_TS(tS_); DA_TS(tI_);
        DA_STEP(pA0, pA1, pB0, pB1, 0);
        DA_STEP(pB0, pB1, pA0, pA1, 1);
    } else {
        DA_START();
        DA_TS(tS_);
        bf16x8 ka_, kb2_, kc_, kd_, qa_;
        { const LAS char* kb_ = kbase + sKc; ka_ = DA_KF(0, 0); kb2_ = DA_KF(0, 1); kc_ = DA_KF(1, 0); kd_ = DA_KF(1, 1); qa_ = qr_(0); }
        int t = 0;
        do {
            DA_STEPX(pA0, pA1, pB0, pB1, t);
            DA_STEPX(pB0, pB1, pA0, pA1, t + 1);
            t += 2;
        } while (t + 2 < NT);
        DA_TS(tI_);
        DA_STEP(pA0, pA1, pB0, pB1, t);
        DA_STEP(pB0, pB1, pA0, pA1, t + 1);
    }
#undef DA_START
#undef DA_DMA_K
#undef DA_TM
#undef DA_DMA_V
#undef DA_QK
#undef DA_MASK
#undef DA_MOVE_REF
#undef DA_STEP
#undef qr_
#undef DA_STEPX
#undef DA_PVGAP
#undef DA_EXP8
#undef DA_VF
#undef DA_KF
#undef DA_GAP
#undef DA_PIN
#undef DA_T
#undef DA_PROF_ACC
#if DA_PROF
    const unsigned tL_ = (unsigned)__builtin_amdgcn_s_memrealtime(); __builtin_amdgcn_sched_barrier(0);
#endif
    int le_ = lane; asm volatile("" : "+v"(le_)); const int r32e = le_ & 31, hie = le_ >> 5;
    { auto rr = __builtin_amdgcn_permlane32_swap(__float_as_uint(lrow), __float_as_uint(lrow), false, false); lrow = __uint_as_float(rr[0]) + __uint_as_float(rr[1]); }
    if (hie == 0) wsf[32 + r32e] = lrow;
    LDS_WAIT();
    float inv[16];
#pragma unroll
    for (int g = 0; g < 4; ++g) { const f32x4 l4 = *(const LAS f32x4*)(wsf + 32 + 8 * g + 4 * hie);
#pragma unroll
        for (int e = 0; e < 4; ++e) inv[4 * g + e] = __builtin_amdgcn_rcpf(l4[e]); }
#define DA_GSW(r) ((r) ^ (((((r) >> 2) ^ ((r) >> 3)) & 1) << 3))
    { const float scl = comp ? lam : 1.0f; const int kq = (r32e >> 2) ^ (4 * hie);
      unsigned wb[2][4];
#pragma unroll
      for (int c = 0; c < 4; ++c) { const unsigned b = (unsigned)((w4 * 32 + 4 * hie) * 512 + (kq ^ c) * 16 + (r32e & 3) * 4 + comp * 65536); wb[0][c] = b + 128u * hie; wb[1][c] = b - 128u * hie; }
#pragma unroll
      for (int r = 0; r < 16; ++r) { const float f = scl * inv[r];
#pragma unroll
          for (int d = 0; d < 4; ++d) *(LAS float*)(lds + wb[d & 1][r & 3] + ((r & 3) + 8 * (r >> 2)) * 512 + d * 128) = o[d][r] * f; } }
    const int rr_ = le_ & 15, qq_ = le_ >> 4, rowl_ = wid * 16 + rr_;
    f32x4 gg[8];
#pragma unroll
    for (int j = 0; j < 8; ++j) gg[j] = *(const f32x4*)(gsub + qq_ * 32 + 4 * j);
    WG_BAR();
    { const LAS float* x0 = (const LAS float*)lds + rowl_ * 128; const int gsw = DA_GSW(rr_);
      f32x4 v[8]; float ss = 0.f;
#pragma unroll
      for (int j = 0; j < 8; ++j) { const int pc = ((qq_ * 8 + j) ^ gsw) << 2; const f32x4 a = *(const LAS f32x4*)(x0 + pc), b = *(const LAS f32x4*)(x0 + 128 * 128 + pc);
          v[j] = a - b; ss += (v[j][0] * v[j][0] + v[j][1] * v[j][1]) + (v[j][2] * v[j][2] + v[j][3] * v[j][3]); }
      ss += __shfl_xor(ss, 16); ss += __shfl_xor(ss, 32);
      const float rs = __builtin_amdgcn_rsqf(ss * (1.0f / 128.0f) + EPS) * (1.0f - LAMBDA_INIT);
      bf16_t* op = O + (rowbase + qb * 128 + rowl_) * ldo + h * 128 + qq_ * 32;
#pragma unroll
      for (int j = 0; j < 8; j += 2) { u32x4 w; const f32x4 a = v[j] * rs * gg[j], b = v[j + 1] * rs * gg[j + 1];
          w.x = cvtpk(a[0], a[1]); w.y = cvtpk(a[2], a[3]); w.z = cvtpk(b[0], b[1]); w.w = cvtpk(b[2], b[3]); *(u32x4*)(op + 4 * j) = w; } }
#undef DA_GSW
    WG_BAR();
#if DA_PROF
    { const unsigned tu1_ = (unsigned)__builtin_amdgcn_s_memrealtime(); if (wid == 0 && le_ == 0) { volatile LAS unsigned* pf_ = (volatile LAS unsigned*)(lds + MISC_OFF) + 3300; pf_[7] += tu1_ - tu0_; pf_[8] += tS_ - tu0_; pf_[9] += tI_ - tS_; pf_[10] += tL_ - tI_; pf_[11] += tu1_ - tL_; } }
#endif
}

constexpr int CA_KOFF = 0, CA_VOFF = 65536;
__device__ __forceinline__ void ca_unit(const int tid, int b, int hm, int qc, const bf16_t* QM, const bf16_t* KM, const bf16_t* VM, bf16_t* OM, int ldo, LAS unsigned char* lds) {
    const int lane = tid & 63, r32 = lane & 31, hi = lane >> 5; const int wid = __builtin_amdgcn_readfirstlane(tid >> 6);
    LAS float* wsf = (LAS float*)(lds + WSF_OFF) + wid * 64;
#pragma unroll
    for (int j = 0; j < 16; ++j) { const int P = wid * 16 + j;
        if (P < 64) { const int kt = P >> 4, ch = P & 15;
            __builtin_amdgcn_global_load_lds((const unsigned*)(KM + (size_t)(b * MEMLEN + 64 * kt + lane) * 512 + hm * 128 + ch * 8), (LAS unsigned*)(lds + CA_KOFF + kt * 16384 + ch * 1024), 16, 0, 0);
        } else { const int P2 = P - 64, kt = P2 >> 4, pv = P2 & 15;
            __builtin_amdgcn_global_load_lds((const unsigned*)(VM + (size_t)(b * MEMLEN + 64 * kt + 16 * (pv & 3) + (lane >> 2)) * 512 + hm * 128 + (pv >> 2) * 32 + (lane & 3) * 8), (LAS unsigned*)(lds + CA_VOFF + kt * 16384 + pv * 1024), 16, 0, 0); } }
    WG_BAR();
    const LAS char* ldc = (const LAS char*)lds;
    const int vlane = ((lane >> 4) & 1) * 32 + (lane & 3) * 8 + (4 * hi + ((lane & 15) >> 2)) * 64;
#pragma unroll 1
    for (int pass = 0; pass < 4; ++pass) {
        const size_t row0 = (size_t)b * SEQ + qc * 1024 + pass * 256 + wid * 32;
        bf16x8 qr[8]; float ssq = 0.f;
        { const bf16_t* Qw = QM + (row0 + r32) * 512 + hm * 128 + hi * 8;
#pragma unroll
          for (int d0 = 0; d0 < 8; ++d0) { qr[d0] = *(const bf16x8*)(Qw + d0 * 16); const u32x4 w = __builtin_bit_cast(u32x4, qr[d0]);
              float a;
              a = bf_lo(w.x); ssq += a * a; a = bf_hi(w.x); ssq += a * a; a = bf_lo(w.y); ssq += a * a; a = bf_hi(w.y); ssq += a * a;
              a = bf_lo(w.z); ssq += a * a; a = bf_hi(w.z); ssq += a * a; a = bf_lo(w.w); ssq += a * a; a = bf_hi(w.w); ssq += a * a; } }
        { auto rr = __builtin_amdgcn_permlane32_swap(__float_as_uint(ssq), __float_as_uint(ssq), false, false); ssq = __uint_as_float(rr[0]) + __uint_as_float(rr[1]); }
        const float rq = __builtin_amdgcn_rsqf(ssq * (1.0f / 128.0f) + EPS);
        float mrow = -__builtin_inff(), lrow = 0.f; f32x16 o[4];
#pragma unroll
        for (int d = 0; d < 4; ++d)
#pragma unroll
            for (int r = 0; r < 16; ++r) o[d][r] = 0.f;
#pragma unroll 1
        for (int kt = 0; kt < 4; ++kt) {
            f32x16 p0, p1;
            qk_tile<8>(p0, p1, ldc + CA_KOFF + kt * 16384 + hi * 1024 + r32 * 16, qr);
#pragma unroll
            for (int r = 0; r < 16; ++r) { p0[r] *= rq; p1[r] *= rq; }
            softmax_pv(p0, p1, mrow, lrow, o, ldc + CA_VOFF + kt * 16384 + vlane, wsf, r32, hi);
        }
        { auto rr = __builtin_amdgcn_permlane32_swap(__float_as_uint(lrow), __float_as_uint(lrow), false, false); lrow = __uint_as_float(rr[0]) + __uint_as_float(rr[1]); }
        if (hi == 0) wsf[32 + r32] = lrow;
        LDS_WAIT();
#pragma unroll
        for (int g = 0; g < 4; ++g) { const f32x4 l4 = *(const LAS f32x4*)(wsf + 32 + 8 * g + 4 * hi);
#pragma unroll
            for (int e = 0; e < 4; ++e) { const float iv = __builtin_amdgcn_rcpf(l4[e]); const int r = 4 * g + e;
                bf16_t* op = OM + (row0 + crow(r, hi)) * ldo + hm * 128 + r32;
#pragma unroll
                for (int d = 0; d < 4; ++d) op[d * 32] = (bf16_t)(cvtpk(o[d][r] * iv, 0.f) & 0xffffu); } }
        LDS_WAIT();
    }
    WG_BAR();
}
#undef MFMA32
}
#define XB_TMO      128
#define XB_XCNT(j)  (256  + 64 * (j))
#define XB_XSUB(j)  (1280 + 64 * (j))
#define XB_XGEN(j)  (2304 + 64 * (j))
#define XB_TOP      3328
#define XB_TOPGEN   3392
#define XCD_BAR_WORDS 3456
#define XB_SPIN_CAP (1u << 18)

__device__ __forceinline__ unsigned xb_ld(unsigned* p)              { return __hip_atomic_load(p, __ATOMIC_RELAXED, __HIP_MEMORY_SCOPE_AGENT); }
__device__ __forceinline__ unsigned xb_add(unsigned* p, unsigned v) { return __hip_atomic_fetch_add(p, v, __ATOMIC_RELAXED, __HIP_MEMORY_SCOPE_AGENT); }
__device__ __forceinline__ unsigned xb_xcc_id() { return (unsigned)__builtin_amdgcn_s_getreg((3 << 11) | 20) & 0xFu; }
#define XB_SPIN(cond, bar) do { unsigned _sp = 0; while (cond) { __builtin_amdgcn_s_sleep(1); \
    if ((++_sp & 255u) == 0u) { if (xb_ld(&(bar)[XB_TMO])) break; if (_sp > XB_SPIN_CAP) { atomicAdd(&(bar)[XB_TMO], 1u); break; } } } } while (0)

struct XcdBarrier { unsigned* bar; unsigned x; volatile LAS unsigned* st; };

__device__ __forceinline__ XcdBarrier xcd_barrier_post(unsigned* bar, volatile LAS unsigned* st) {
    XcdBarrier b; b.bar = bar; b.x = xb_xcc_id(); b.st = st;
    if (threadIdx.x == 0) (void)xb_add(&bar[XB_XCNT(b.x)], 1u);
    return b;
}
__device__ __forceinline__ void xcd_barrier_complete(unsigned* bar, unsigned x, unsigned& nloc, unsigned& nx) {
    const unsigned G = gridDim.x * gridDim.y * gridDim.z;
    unsigned sum, cnt, mine, sp = 0u;
    for (;;) {
        sum = 0u; cnt = 0u; mine = 0u;
#pragma unroll 1
        for (unsigned j = 0; j < 16; ++j) { const unsigned c = xb_ld(&bar[XB_XCNT(j)]); sum += c; cnt += (c > 0u) ? 1u : 0u; mine = (j == x) ? c : mine; }
        if (sum == G) break;
        __builtin_amdgcn_s_sleep(1);
        if ((++sp & 255u) == 0u) { if (xb_ld(&bar[XB_TMO])) break; if (sp > XB_SPIN_CAP) { atomicAdd(&bar[XB_TMO], 1u); break; } }
    }
    nloc = mine > 0u ? mine : 1u; nx = cnt > 0u ? cnt : 1u;
}
__device__ __forceinline__ void xcd_barrier(const XcdBarrier& b) {
    asm volatile("s_waitcnt vmcnt(0)" ::: "memory");
    __syncthreads();
    if (threadIdx.x == 0) {
        unsigned* bar = b.bar;
        __builtin_amdgcn_s_waitcnt(0);
        unsigned nloc = b.st[0], nx = b.st[1];
        if (nloc == 0u) { xcd_barrier_complete(bar, b.x, nloc, nx); b.st[0] = nloc; b.st[1] = nx; }
        const unsigned old = xb_add(&bar[XB_XSUB(b.x)], 1u);
        const unsigned gen = old / nloc;
        if (old + 1u == (gen + 1u) * nloc) {
            __builtin_amdgcn_fence(__ATOMIC_RELEASE, "agent");
            asm volatile("s_waitcnt vmcnt(0)" ::: "memory");
            const unsigned og = xb_add(&bar[XB_TOP], 1u);
            const unsigned tg = og / nx;
            if (og + 1u == (tg + 1u) * nx) xb_add(&bar[XB_TOPGEN], 1u);
            else XB_SPIN(xb_ld(&bar[XB_TOPGEN]) == tg, bar);
            __builtin_amdgcn_fence(__ATOMIC_ACQUIRE, "agent");
            xb_add(&bar[XB_XGEN(b.x)], 1u);
            asm volatile("s_waitcnt vmcnt(0)" ::: "memory");
        } else {
            XB_SPIN(xb_ld(&bar[XB_XGEN(b.x)]) == gen, bar);
            __builtin_amdgcn_fence(__ATOMIC_ACQUIRE, "agent");
            asm volatile("s_waitcnt vmcnt(0)" ::: "memory");
        }
    }
    __syncthreads();
}

typedef __attribute__((address_space(4))) const unsigned char* kptr_t;
__device__ __forceinline__ kptr_t karg_base() { kptr_t kp = (kptr_t)__builtin_amdgcn_kernarg_segment_ptr(); asm volatile("" : "+s"(kp)); return kp; }
typedef const float* cfptr_t; typedef float* fptr_t; typedef unsigned char* ucptr_t;
struct InTab { __device__ __forceinline__ const float* operator[](int i) const { return *(const __attribute__((address_space(4))) cfptr_t*)(karg_base() + 8 * i); } };
struct Frame {
    LAS unsigned char* lds; volatile LAS unsigned* MISC; unsigned* ctl;
    int tid, lane, wave, vcu, G;
    InTab in; float* out; unsigned char* ws;
};
#define MKFRAME(F) Frame F; { int w_ = wave_s; asm volatile("" : "+s"(w_)); int t_; asm volatile("v_mbcnt_lo_u32_b32 %0, -1, 0\n\tv_mbcnt_hi_u32_b32 %0, -1, %0" : "=v"(t_)); F.lane = t_; F.wave = w_; F.tid = w_ * 64 + t_; \
    F.lds = (LAS unsigned char*)lds_raw; F.MISC = (volatile LAS unsigned*)(F.lds + MISC_OFF); F.G = gridDim.x; { const int bx_ = blockIdx.x; F.vcu = (F.G % 8 == 0) ? (bx_ % 8) * (F.G / 8) + bx_ / 8 : bx_; } \
    F.out = *(const __attribute__((address_space(4))) fptr_t*)(karg_base() + 31 * 8); F.ws = *(const __attribute__((address_space(4))) ucptr_t*)(karg_base() + 32 * 8); F.ctl = (unsigned*)(F.ws + WS_CTL); }
enum { I_X = 0, I_MEM, I_GMIX, I_WIN, I_BG, I_QN, I_KN, I_LQ1, I_LK1, I_LQ2, I_LK2, I_GSUB, I_PW, I_PS, I_GMEM, I_WKV, I_MQ, I_MK, I_WBA, I_WBP, I_WBM, I_WOUT, I_GFFN, I_WR, I_BR,
       I_WG, I_BGATE, I_WU, I_BUP, I_WD, I_BDOWN };
constexpr int MI_CNT = 16, MI_CUM = 48, MI_LC = 96, MI_LB = 128, MI_RB = 256;

template <int MAP> __device__ __forceinline__ int rowmap(int n) {
    if (MAP == 1) { if (n >= 2048) return n; const int nl = n & 255; return (n & ~255) + 128 * ((nl >> 5) & 1) + 32 * (nl >> 6) + (nl & 31); }
    if (MAP == 4 || MAP == 5) {
        const int gt = (MAP == 4) ? 3 : (n >> 10), ch = n & 1023, cl = ch & 63;
        return 256 * (ch >> 6) + 128 * (gt >> 1) + 32 * (cl >> 4) + 8 * ((cl >> 2) & 3) + 4 * (gt & 1) + (cl & 3); }
    if (MAP == 2) return 256 * (n >> 7) + (n & 127);
    if (MAP == 3) return 256 * (n >> 7) + 128 + (n & 127);
    return n;
}
template <int MAP> __device__ __forceinline__ void transpose_item(const float* W, int K, int N, int ld, bf16_t* WT, const float* kscale, LAS float* scr, int item, int lane, int ldk = 0) {
    if (ldk == 0) ldk = K;
    const int nblk = N / 32, kb = item / nblk, nb = item % nblk, k0 = 64 * kb, n0 = 32 * nb;
#pragma unroll
    for (int i = 0; i < 8; ++i) { const int kk = 8 * i + (lane >> 3), nn = (lane & 7) * 4;
        f32x4 v = *(const f32x4*)(W + (size_t)(k0 + kk) * ld + n0 + nn);
        if (kscale) v = v * kscale[k0 + kk];
        LAS float* s = scr + kk * 33 + nn; s[0] = v[0]; s[1] = v[1]; s[2] = v[2]; s[3] = v[3]; }
    LDS_WAIT(); asm volatile("" ::: "memory");
    const int c = lane & 7;
#pragma unroll
    for (int j = 0; j < 4; ++j) { const int n = (lane >> 3) + 8 * j; const LAS float* s = scr + (8 * c) * 33 + n;
        u32x4 o; o.x = cvtpk(s[0 * 33], s[1 * 33]); o.y = cvtpk(s[2 * 33], s[3 * 33]); o.z = cvtpk(s[4 * 33], s[5 * 33]); o.w = cvtpk(s[6 * 33], s[7 * 33]);
        *(u32x4*)(WT + (size_t)rowmap<MAP>(n0 + n) * ldk + k0 + 8 * c) = o; }
    LDS_WAIT(); asm volatile("" ::: "memory");
}
__device__ __forceinline__ void rms_row_to_bf16(const float* xrow, const float* gain, bf16_t* orow, int lane) {
    const f32x4* xr = (const f32x4*)xrow + lane; const f32x4* gr = (const f32x4*)gain + lane;
    f32x4 v[4]; float s = 0.f;
#pragma unroll
    for (int j = 0; j < 4; ++j) { v[j] = xr[64 * j]; s += (v[j].x * v[j].x + v[j].y * v[j].y) + (v[j].z * v[j].z + v[j].w * v[j].w); }
    const float rstd = __builtin_amdgcn_rsqf(wave_sum(s) * (1.f / DM) + EPS);
    u32x2* o8 = (u32x2*)orow + lane;
#pragma unroll
    for (int j = 0; j < 4; ++j) { const f32x4 g = gr[64 * j]; u32x2 w; w.x = cvtpk(v[j].x * rstd * g.x, v[j].y * rstd * g.y); w.y = cvtpk(v[j].z * rstd * g.z, v[j].w * rstd * g.w); o8[64 * j] = w; }
}

template <int MAP> __device__ __forceinline__ void transpose_item8(const float* W, int K, int N, int ld, unsigned char* WT, const float* kscale, LAS float* scr, int item, int lane) {
    const int nblk = N / 32, kb = item / nblk, nb = item % nblk, k0 = 64 * kb, n0 = 32 * nb;
#pragma unroll
    for (int i = 0; i < 8; ++i) { const int kk = 8 * i + (lane >> 3), nn = (lane & 7) * 4;
        f32x4 v = *(const f32x4*)(W + (size_t)(k0 + kk) * ld + n0 + nn);
        v = v * (kscale ? kscale[k0 + kk] * W8_SCALE : W8_SCALE);
        LAS float* s = scr + kk * 33 + nn; s[0] = v[0]; s[1] = v[1]; s[2] = v[2]; s[3] = v[3]; }
    LDS_WAIT(); asm volatile("" ::: "memory");
    { const int n = lane >> 1, kh = lane & 1; const LAS float* s = scr + (32 * kh) * 33 + n;
      u32x4 o0, o1;
      o0.x = cvt4_fp8(s[0 * 33], s[1 * 33], s[2 * 33], s[3 * 33]);     o0.y = cvt4_fp8(s[4 * 33], s[5 * 33], s[6 * 33], s[7 * 33]);
      o0.z = cvt4_fp8(s[8 * 33], s[9 * 33], s[10 * 33], s[11 * 33]);   o0.w = cvt4_fp8(s[12 * 33], s[13 * 33], s[14 * 33], s[15 * 33]);
      o1.x = cvt4_fp8(s[16 * 33], s[17 * 33], s[18 * 33], s[19 * 33]); o1.y = cvt4_fp8(s[20 * 33], s[21 * 33], s[22 * 33], s[23 * 33]);
      o1.z = cvt4_fp8(s[24 * 33], s[25 * 33], s[26 * 33], s[27 * 33]); o1.w = cvt4_fp8(s[28 * 33], s[29 * 33], s[30 * 33], s[31 * 33]);
      unsigned char* op = WT + (size_t)rowmap<MAP>(n0 + n) * K + k0 + 32 * kh;
      *(u32x4*)op = o0; *(u32x4*)(op + 16) = o1; }
    LDS_WAIT(); asm volatile("" ::: "memory");
}
__device__ __forceinline__ void p0_prologue(Frame& F) {
    LAS float* scr = (LAS float*)(F.lds + F.wave * 16384);
    const int gw = F.vcu * NWAVES + F.wave, NGW = F.G * NWAVES;
    unsigned char* ws = F.ws;
    constexpr int I_IN = (DM / 64) * (2048 / 32), I_UP = (DM / 64) * (512 / 32), I_V8 = (DM / 64) * (1024 / 32), I_GT8 = (DM / 64) * (3072 / 32), I_QM8 = (DM / 64) * (512 / 32), I_SQ = (DM / 64) * (DM / 32), I_BM = (512 / 64) * (DM / 32);
    constexpr int NITEMS = I_IN + I_UP + I_V8 + I_GT8 + I_QM8 + 3 * I_SQ + I_BM;
    for (int it = gw; it < NITEMS; it += NGW) {
        int r = it;
        if (r < I_IN) { transpose_item8<1>(F.in[I_WIN], DM, 2048, IN_DIM, ws + WS_WIN8, nullptr, scr, r, F.lane); continue; } r -= I_IN;
        if (r < I_UP) { transpose_item<0>(F.in[I_WIN] + 3072, DM, 512, IN_DIM, (bf16_t*)(ws + WS_WIN), nullptr, scr, r, F.lane); continue; } r -= I_UP;
        if (r < I_V8) { transpose_item8<4>(F.in[I_WIN] + 2048, DM, 1024, IN_DIM, ws + WS_WIN8 + (size_t)2048 * DM, nullptr, scr, r, F.lane); continue; } r -= I_V8;
        if (r < I_GT8) { transpose_item8<5>(F.in[I_WIN] + 4096, DM, 3072, IN_DIM, ws + WS_WIN8 + (size_t)2048 * DM, nullptr, scr, r, F.lane); continue; } r -= I_GT8;
        if (r < I_QM8) { transpose_item8<0>(F.in[I_WIN] + 3584, DM, 512, IN_DIM, ws + WS_WIN8 + (size_t)6144 * DM, nullptr, scr, r, F.lane); continue; } r -= I_QM8;
        if (r < I_SQ) { transpose_item<0>(F.in[I_WKV], DM, DM, DM, (bf16_t*)(ws + WS_WKV), nullptr, scr, r, F.lane); continue; } r -= I_SQ;
        if (r < I_SQ) { transpose_item<0>(F.in[I_WBA], DM, DM, DM, (bf16_t*)(ws + WS_WCAT), nullptr, scr, r, F.lane, BR_LD); continue; } r -= I_SQ;
        if (r < I_SQ) { transpose_item<0>(F.in[I_WOUT], DM, DM, DM, (bf16_t*)(ws + WS_WOUT), nullptr, scr, r, F.lane); continue; } r -= I_SQ;
        transpose_item<0>(F.in[I_WBM], 512, DM, DM, (bf16_t*)(ws + WS_WCAT) + BR_OM, nullptr, scr, r, F.lane, BR_LD);
    }
    { const float* pw = F.in[I_PW]; const float* ps = F.in[I_PS]; const float* wbp = F.in[I_WBP]; bf16_t* WE = (bf16_t*)(ws + WS_WCAT) + BR_Z;
      const int gt = F.vcu * 512 + F.tid, NGT = F.G * 512;
      for (int it = gt; it < 512 * (DM / 4); it += NGT) { const int d4 = it & (DM / 4 - 1), gc = it >> 8, g = gc >> 7;
          f32x4 a = {0.f, 0.f, 0.f, 0.f};
#pragma unroll 8
          for (int j = 0; j < 128; ++j) { const float c = pw[gc * 128 + j] * ps[g * 128 + j]; a += *(const f32x4*)(wbp + (size_t)(g * 128 + j) * DM + 4 * d4) * c; }
#pragma unroll
          for (int i = 0; i < 4; ++i) WE[(size_t)(4 * d4 + i) * BR_LD + gc] = (bf16_t)(cvtpk(a[i], 0.f) & 0xffffu); }
      float* cs = (float*)(ws + WS_ROPE); float* sn = cs + SEQ * 32;
      for (int it = gt; it < SEQ * 32; it += NGT) { const int pos = it >> 5, j = it & 31;
          const float invf = exp2f(-(float)(2 * j) * (1.0f / 64.0f) * 13.287712379549449f);
          const float ang = (float)pos * invf;
          const double rev = (double)ang * 0.15915494309189535; const float fr = (float)(rev - floor(rev));
          cs[it] = __builtin_amdgcn_cosf(fr); sn[it] = __builtin_amdgcn_sinf(fr); }
      { bf16_t* wr = (bf16_t*)(ws + WS_WR); const float* wrs = F.in[I_WR]; const float* gf = F.in[I_GFFN];
        for (int it = gt; it < DM * NE; it += NGT) { const int k = it >> 5, e = it & 31; const float w = gf[k] * wrs[it];
            const unsigned hi = cvtpk(w, 0.f) & 0xffffu; const float rem = w - __uint_as_float(hi << 16); const unsigned lo = cvtpk(rem, 0.f) & 0xffffu;
            const int off = (k >> 4) * 512 + ((k >> 3) & 1) * 256 + e * 8 + (k & 7);
            wr[off] = (bf16_t)hi; wr[32768 + off] = (bf16_t)lo; } }
    }
    { const float* X = F.in[I_X]; const float* gm = F.in[I_GMIX]; bf16_t* XN = (bf16_t*)(ws + WS_A);
      f32x4 nx[4];
#pragma unroll
      for (int j = 0; j < 4; ++j) nx[j] = ((const f32x4*)(X + (size_t)gw * DM) + F.lane)[64 * j];
      for (int m = gw; m < T; m += NGW) {
          f32x4 v[4]; float s = 0.f;
#pragma unroll
          for (int j = 0; j < 4; ++j) { v[j] = nx[j]; s += (v[j].x * v[j].x + v[j].y * v[j].y) + (v[j].z * v[j].z + v[j].w * v[j].w); }
          { const int mn = (m + NGW < T) ? m + NGW : m;
#pragma unroll
            for (int j = 0; j < 4; ++j) nx[j] = ((const f32x4*)(X + (size_t)mn * DM) + F.lane)[64 * j]; }
          const float rstd = __builtin_amdgcn_rsqf(wave_sum(s) * (1.f / DM) + EPS);
          u32x2* o8 = (u32x2*)(XN + (size_t)m * DM) + F.lane; unsigned* o4 = (unsigned*)(ws + WS_XN8 + (size_t)m * DM) + F.lane;
#pragma unroll
          for (int j = 0; j < 4; ++j) { const f32x4 g = ((const f32x4*)gm + F.lane)[64 * j]; const f32x4 y = v[j] * rstd * g;
              u32x2 w; w.x = cvtpk(y.x, y.y); w.y = cvtpk(y.z, y.w); o8[64 * j] = w; o4[64 * j] = cvt4_fp8(y.x, y.y, y.z, y.w); }
      } }
    for (int m = gw; m < TM; m += NGW) rms_row_to_bf16(F.in[I_MEM] + (size_t)m * DM, F.in[I_GMEM], (bf16_t*)(ws + WS_MEMN) + (size_t)m * DM, F.lane);
}

template <int W> __device__ __forceinline__ void pool_item(const bf16_t* U, bf16_t* Z, int t, int ch) {
    const int pos = t & (SEQ - 1);
    u32x4 c[W];
#pragma unroll
    for (int j = 0; j < W; ++j) { const int tj = (pos - j >= 0) ? t - j : t; c[j] = *(const u32x4*)(U + (size_t)tj * 512 + ch * 8); }
    float a[8] = {0.f, 0.f, 0.f, 0.f, 0.f, 0.f, 0.f, 0.f};
#pragma unroll
    for (int j = 0; j < W; ++j) { const float m = (pos - j >= 0) ? 1.0f : 0.0f;
        a[0] += m * bf_lo(c[j].x); a[1] += m * bf_hi(c[j].x); a[2] += m * bf_lo(c[j].y); a[3] += m * bf_hi(c[j].y); a[4] += m * bf_lo(c[j].z); a[5] += m * bf_hi(c[j].z); a[6] += m * bf_lo(c[j].w); a[7] += m * bf_hi(c[j].w); }
    const int cntw = (pos + 1 < W) ? pos + 1 : W; const float ic = 1.0f / (float)cntw;
    u32x4 o;
    o.x = cvtpk(a[0] * ic - bf_lo(c[0].x), a[1] * ic - bf_hi(c[0].x)); o.y = cvtpk(a[2] * ic - bf_lo(c[0].y), a[3] * ic - bf_hi(c[0].y));
    o.z = cvtpk(a[4] * ic - bf_lo(c[0].z), a[5] * ic - bf_hi(c[0].z)); o.w = cvtpk(a[6] * ic - bf_lo(c[0].w), a[7] * ic - bf_hi(c[0].w));
    *(u32x4*)(Z + (size_t)t * BR_LD + ch * 8) = o;
}
__device__ __forceinline__ void p2_pool(Frame& F) {
    const bf16_t* U = (const bf16_t*)(F.ws + WS_UP); bf16_t* Z = (bf16_t*)(F.ws + WS_A) + BR_Z;
    const int gw = F.vcu * NWAVES + F.wave, NGW = F.G * NWAVES;
    for (int it = gw; it < (T / 4) * 4; it += NGW) {
        const int g = it & 3, t = (it >> 2) * 4 + (F.lane >> 4), ch = g * 16 + (F.lane & 15);
        if (g == 0) pool_item<2>(U, Z, t, ch); else if (g == 1) pool_item<4>(U, Z, t, ch); else if (g == 2) pool_item<8>(U, Z, t, ch); else pool_item<16>(U, Z, t, ch);
    }
}

__device__ __forceinline__ void p5_router(Frame& F) {
    const bf16_t* H = (const bf16_t*)(F.ws + WS_A); const float* br = F.in[I_BR];
    unsigned* tslot = (unsigned*)(F.ws + WS_TSLOT); float* tw = (float*)(F.ws + WS_TW); float* rstd_o = (float*)(F.ws + WS_RSTD); unsigned* list = (unsigned*)(F.ws + WS_LIST); float* rslot = (float*)(F.ws + WS_RSLOT);
    { const u32x4* src = (const u32x4*)(F.ws + WS_WR); LAS u32x4* dst = (LAS u32x4*)F.lds;
      for (int i = F.tid; i < 131072 / 16; i += 512) dst[i] = src[i]; }
    volatile LAS unsigned* LC = F.MISC + MI_LC; volatile LAS unsigned* LB = F.MISC + MI_LB;
    WG_BAR();
    const int r32 = F.lane & 31, hi = F.lane >> 5;
    const LAS char* wa = (const LAS char*)F.lds + hi * 512 + r32 * 16;
    float bre[16];
#pragma unroll
    for (int r = 0; r < 16; ++r) bre[r] = br[(r & 3) + 8 * (r >> 2) + 4 * hi];
    for (int chunk = F.vcu; chunk < T / 256; chunk += F.G) {
        const int base = chunk * 256;
        if (F.tid < NE) LC[F.tid] = 0u;
        WG_BAR();
        const int row = base + F.wave * 32 + r32;
        const bf16_t* hp = H + (size_t)row * DM + hi * 8;
        f32x16 acc, acs;
#pragma unroll
        for (int r = 0; r < 16; ++r) { acc[r] = 0.f; acs[r] = 0.f; }
#pragma unroll 1
        for (int kb = 0; kb < 64; kb += 16) {
            bf16x8 hfr[16];
#pragma unroll
            for (int i = 0; i < 16; ++i) hfr[i] = *(const bf16x8*)(hp + (kb + i) * 16);
#pragma unroll
            for (int i = 0; i < 16; ++i) { const bf16x8 a0 = *(const LAS bf16x8*)(wa + (kb + i) * 1024), a1 = *(const LAS bf16x8*)(wa + 65536 + (kb + i) * 1024);
                acc = __builtin_amdgcn_mfma_f32_32x32x16_bf16(a0, hfr[i], acc, 0, 0, 0);
                acc = __builtin_amdgcn_mfma_f32_32x32x16_bf16(a1, hfr[i], acc, 0, 0, 0);
                acs = __builtin_amdgcn_mfma_f32_32x32x16_bf16(hfr[i], hfr[i], acs, 0, 0, 0); }
        }
        float dg = 0.f; { const int rsel = (r32 & 3) + 4 * (r32 >> 3);
#pragma unroll
            for (int r = 0; r < 16; ++r) dg = (rsel == r) ? acs[r] : dg; }
        { auto rr = __builtin_amdgcn_permlane32_swap(__float_as_uint(dg), __float_as_uint(dg), false, false); const float oth = (hi == 0) ? __uint_as_float(rr[1]) : __uint_as_float(rr[0]);
          dg = (hi == ((r32 >> 2) & 1)) ? dg : oth; }
        const float rstd = __builtin_amdgcn_rsqf(dg * (1.0f / DM) + EPS);
        float v[16];
#pragma unroll
        for (int r = 0; r < 16; ++r) v[r] = acc[r] * rstd + bre[r];
        float tv[8]; int te[8];
#pragma unroll
        for (int k = 0; k < 4; ++k) { float m = v[0]; int mi = 0;
#pragma unroll
            for (int r = 1; r < 16; ++r) { const bool g = v[r] > m; m = g ? v[r] : m; mi = g ? r : mi; }
            tv[k] = m; te[k] = (mi & 3) + 8 * (mi >> 2) + 4 * hi;
#pragma unroll
            for (int r = 0; r < 16; ++r) v[r] = (r == mi) ? -__builtin_inff() : v[r]; }
#pragma unroll
        for (int k = 0; k < 4; ++k) { auto a = __builtin_amdgcn_permlane32_swap(__float_as_uint(tv[k]), __float_as_uint(tv[k]), false, false); auto b = __builtin_amdgcn_permlane32_swap((unsigned)te[k], (unsigned)te[k], false, false);
            tv[4 + k] = (hi == 0) ? __uint_as_float(a[1]) : __uint_as_float(a[0]); te[4 + k] = (hi == 0) ? (int)b[1] : (int)b[0]; }
        float sv[4]; int se[4];
#pragma unroll
        for (int k = 0; k < 4; ++k) { float m = tv[0]; int me = te[0]; int mi = 0;
#pragma unroll
            for (int c = 1; c < 8; ++c) { const bool g = (tv[c] > m) || (tv[c] == m && te[c] < me); m = g ? tv[c] : m; me = g ? te[c] : me; mi = g ? c : mi; }
            sv[k] = m; se[k] = me;
#pragma unroll
            for (int c = 0; c < 8; ++c) tv[c] = (c == mi) ? -__builtin_inff() : tv[c]; }
        const float e1 = __expf(sv[1] - sv[0]), e2 = __expf(sv[2] - sv[0]), e3 = __expf(sv[3] - sv[0]); const float is = 1.0f / (1.0f + e1 + e2 + e3);
        unsigned myE = 0u, myR = 0u;
        if (hi == 0) {
#pragma unroll
            for (int k = 0; k < 4; ++k) { const unsigned rk = __hip_atomic_fetch_add((LAS unsigned*)&LC[se[k]], 1u, __ATOMIC_RELAXED, __HIP_MEMORY_SCOPE_WORKGROUP); myE |= (unsigned)se[k] << (8 * k); myR |= rk << (8 * k); }
            rstd_o[row] = rstd;
        }
        WG_BAR();
        if (F.tid < NE) LB[F.tid] = xb_add(F.ctl + CW_CNT + F.tid, LC[F.tid]);
        WG_BAR();
        if (hi == 0) {
            u32x4 ts; const f32x4 wv = {is, e1 * is, e2 * is, e3 * is};
#pragma unroll
            for (int k = 0; k < 4; ++k) { const unsigned e = (myE >> (8 * k)) & 0xffu, rnk = (myR >> (8 * k)) & 0xffu; const unsigned pos = LB[e] + rnk;
                ts[k] = (e << 24) | pos; list[(size_t)e * CAP + pos] = (unsigned)row; rslot[(size_t)e * CAP + pos] = rstd; }
            *(u32x4*)(tslot + (size_t)row * 4) = ts; *(f32x4*)(tw + (size_t)row * 4) = wv;
        }
        WG_BAR();
    }
}
__device__ __forceinline__ void p5_expert_weights(Frame& F) {
    LAS float* scr = (LAS float*)(F.lds + F.wave * 16384);
    const int gw = F.vcu * NWAVES + F.wave, NGW = F.G * NWAVES, lane = F.lane;
    constexpr int I_SQ = (DM / 64) * (DM / 32), NIT = 3 * NE * I_SQ;
    const float* gf = F.in[I_GFFN];
    f32x4 nx[8];
#define XW_SRC(it_, kk_) ({ const int mat_ = (it_) / I_SQ, r_ = (it_) % I_SQ, kind_ = mat_ / NE, e_ = mat_ % NE; const float* W_ = F.in[kind_ == 0 ? I_WG : (kind_ == 1 ? I_WU : I_WD)] + (size_t)e_ * DM * DM; \
        W_ + (size_t)(64 * (r_ / 32) + (kk_)) * DM + 32 * (r_ % 32) + (lane & 7) * 4; })
    if (gw < NIT) {
#pragma unroll
        for (int i = 0; i < 8; ++i) nx[i] = *(const f32x4*)XW_SRC(gw, 8 * i + (lane >> 3)); }
    for (int it = gw; it < NIT; it += NGW) {
        const int mat = it / I_SQ, r = it % I_SQ, kind = mat / NE, e = mat % NE, k0 = 64 * (r / 32), n0 = 32 * (r % 32);
#pragma unroll
        for (int i = 0; i < 8; ++i) { const int kk = 8 * i + (lane >> 3), nn = (lane & 7) * 4;
            const f32x4 v = nx[i] * (kind < 2 ? gf[k0 + kk] * W8_SCALE : W8_SCALE);
            LAS float* s = scr + kk * 33 + nn; s[0] = v[0]; s[1] = v[1]; s[2] = v[2]; s[3] = v[3]; }
        { const int itn = (it + NGW < NIT) ? it + NGW : it;
#pragma unroll
          for (int i = 0; i < 8; ++i) nx[i] = *(const f32x4*)XW_SRC(itn, 8 * i + (lane >> 3)); }
        LDS_WAIT(); asm volatile("" ::: "memory");
        { const int n = lane >> 1, kh = lane & 1; const LAS float* s = scr + (32 * kh) * 33 + n;
          u32x4 o0, o1;
          o0.x = cvt4_fp8(s[0 * 33], s[1 * 33], s[2 * 33], s[3 * 33]);     o0.y = cvt4_fp8(s[4 * 33], s[5 * 33], s[6 * 33], s[7 * 33]);
          o0.z = cvt4_fp8(s[8 * 33], s[9 * 33], s[10 * 33], s[11 * 33]);   o0.w = cvt4_fp8(s[12 * 33], s[13 * 33], s[14 * 33], s[15 * 33]);
          o1.x = cvt4_fp8(s[16 * 33], s[17 * 33], s[18 * 33], s[19 * 33]); o1.y = cvt4_fp8(s[20 * 33], s[21 * 33], s[22 * 33], s[23 * 33]);
          o1.z = cvt4_fp8(s[24 * 33], s[25 * 33], s[26 * 33], s[27 * 33]); o1.w = cvt4_fp8(s[28 * 33], s[29 * 33], s[30 * 33], s[31 * 33]);
          const int nrow = n0 + n; const int orow = kind == 0 ? rowmap<2>(nrow) : (kind == 1 ? rowmap<3>(nrow) : nrow);
          unsigned char* op = (kind < 2 ? F.ws + WS_WGU8 + (size_t)e * 2048 * DM : F.ws + WS_WD8 + (size_t)e * DM * DM) + (size_t)orow * DM + k0 + 32 * kh;
          *(u32x4*)op = o0; *(u32x4*)(op + 16) = o1; }
        LDS_WAIT(); asm volatile("" ::: "memory");
    }
#undef XW_SRC
}
__device__ __forceinline__ void moe_tables(Frame& F) {
    WG_BAR();
    if (F.wave == 0) {
        const int n = F.lane < NE ? (int)xb_ld(F.ctl + CW_CNT + F.lane) : 0; const int nb = (n + 255) >> 8; int x = nb;
#pragma unroll
        for (int o = 1; o < 32; o <<= 1) { const int t = __shfl_up(x, o); if (F.lane >= o) x += t; }
        if (F.lane < NE) { F.MISC[MI_CNT + F.lane] = (unsigned)n; F.MISC[MI_CUM + F.lane] = (unsigned)(x - nb);
            for (int rb = x - nb; rb < x; ++rb) F.MISC[MI_RB + rb] = (unsigned)F.lane; }
        if (F.lane == NE - 1) F.MISC[MI_CUM + NE] = (unsigned)x;
    }
    WG_BAR();
}
__device__ __forceinline__ void moe_combine(Frame& F) {
    const unsigned* tslot = (const unsigned*)(F.ws + WS_TSLOT); const float* tw = (const float*)(F.ws + WS_TW); const unsigned char* OS = F.ws + WS_OSLOT;
    const int gw = F.vcu * NWAVES + F.wave, NGW = F.G * NWAVES;
    u32x4 tsn = *(const u32x4*)(tslot + (size_t)gw * 4); f32x4 wvn = *(const f32x4*)(tw + (size_t)gw * 4);
    for (int t = gw; t < T; t += NGW) {
        const u32x4 ts = tsn; const f32x4 wv = wvn;
        { const int tn = (t + NGW < T) ? t + NGW : t; tsn = *(const u32x4*)(tslot + (size_t)tn * 4); wvn = *(const f32x4*)(tw + (size_t)tn * 4); }
        f32x4 a[4]; float* op = F.out + (size_t)t * DM + 4 * F.lane;
        { const bf16_t* hp = (const bf16_t*)(F.ws + WS_A) + (size_t)t * DM + 4 * F.lane;
#pragma unroll
          for (int j = 0; j < 4; ++j) { const u32x2 v = *(const u32x2*)(hp + 256 * j); a[j][0] = bf_lo(v.x); a[j][1] = bf_hi(v.x); a[j][2] = bf_lo(v.y); a[j][3] = bf_hi(v.y); } }
#pragma unroll
        for (int k = 0; k < 4; ++k) { const unsigned e = ts[k] >> 24, pos = ts[k] & 0xffffffu; const size_t prow = (size_t)F.MISC[MI_CUM + e] * 256 + pos; const float w = wv[k] * (1.0f / OS_SCALE);
            const unsigned char* rp = OS + prow * DM + 4 * F.lane;
#pragma unroll
            for (int j = 0; j < 4; ++j) { const int v = *(const int*)(rp + 256 * j); const f32x2 lo = __builtin_amdgcn_cvt_pk_f32_fp8(v, false), hi = __builtin_amdgcn_cvt_pk_f32_fp8(v, true);
                a[j][0] += w * lo.x; a[j][1] += w * lo.y; a[j][2] += w * hi.x; a[j][3] += w * hi.y; } }
#pragma unroll
        for (int j = 0; j < 4; ++j) *(f32x4*)(op + 256 * j) = a[j];
    }
}
#ifndef MK_SPLIT
#define MK_SPLIT 0
#endif
constexpr int N_PHASES = 9;
#ifndef MK_P2_REP_A
#define MK_P2_REP_A 1
#define MK_P2_REP_B 1
#define MK_P2_REP_C 1
#endif
#ifndef MK_REP_MASK
#define MK_REP_MASK 0
#endif
struct Args { const float* in[31]; float* out; unsigned char* ws; int ph_lo, ph_hi; };
static_assert(sizeof(Args) == 31 * 8 + 8 + 8 + 8, "no padding bytes in Args");

__global__ void __launch_bounds__(NWAVES * 64, 2) mk_fwd(Args args) {
    extern __shared__ __attribute__((aligned(16))) unsigned char lds_raw[];
    const int lo = args.ph_lo, hi = args.ph_hi;
#if GP_PROF
    const unsigned long long kt0_ = __builtin_amdgcn_s_memrealtime();
#endif
    const int wave_s = __builtin_amdgcn_readfirstlane((int)threadIdx.x >> 6);
    XcdBarrier bar;
    { MKFRAME(F0);
      for (int u = F0.tid; u < (LDS_BYTES - MISC_OFF) / 4; u += NWAVES * 64) ((LAS unsigned*)(F0.lds + MISC_OFF))[u] = 0u;
      __syncthreads();
      bar.bar = F0.ctl + CW_BAR; bar.x = 0; bar.st = nullptr;
      if (!MK_SPLIT) bar = xcd_barrier_post(F0.ctl + CW_BAR, F0.MISC + 8); }
#define IN(k) (lo <= (k) && (k) < hi)
#ifndef MK_SEAM_REP
#define MK_SEAM_REP 1
#endif
#define SEAM(k) do { if (!MK_SPLIT && IN(k) && IN((k) + 1)) { _Pragma("unroll 1") for (int sr_ = 0; sr_ < (((k) == 3) ? MK_SEAM_REP : 1); ++sr_) xcd_barrier(bar); } } while (0)
#if GP_PROF
#define PH_T0() const unsigned long long pht0_ = __builtin_amdgcn_s_memrealtime()
#define PH_SPIN(F, id) do { if ((id) + 100 == GP_PROF_PHASE) { WG_BAR(); if ((F).wave == 0) { const unsigned long long s_ = __builtin_amdgcn_s_memrealtime(); const unsigned long long n_ = (GP_PROF_SEL >= 1000) ? (unsigned long long)GP_PROF_SEL : (s_ - pht0_) * GP_PROF_MUL; \
        while ((unsigned long long)__builtin_amdgcn_s_memrealtime() - s_ < n_) __builtin_amdgcn_s_sleep(8); } WG_BAR(); } } while (0)
#else
#define PH_T0() do { } while (0)
#define PH_SPIN(F, id) do { } while (0)
#endif
#if GP_PROF
#define GP_RESET(F) do { if ((F).tid < 4) (F).MISC[3320 + (F).tid] = 0u; WG_BAR(); } while (0)
#define GP_SPIN(F, id) do { WG_BAR(); if ((id) == GP_PROF_PHASE) { if ((F).wave == 0) { const unsigned n_ = (GP_PROF_SEL < 4) ? (F).MISC[3320 + (GP_PROF_SEL & 3)] * GP_PROF_MUL : (unsigned)GP_PROF_SEL; \
        const unsigned long long s_ = __builtin_amdgcn_s_memrealtime(); while ((unsigned long long)__builtin_amdgcn_s_memrealtime() - s_ < (unsigned long long)n_) __builtin_amdgcn_s_sleep(8); } WG_BAR(); } } while (0)
#else
#define GP_RESET(F) do { } while (0)
#define GP_SPIN(F, id) do { } while (0)
#endif
#define XA_(F) ((bf16_t*)((F).ws + WS_A))
#define QB_(F) ((bf16_t*)(F).out)
#define KB_(F) ((bf16_t*)(F).out + (size_t)T * DM)
#define VB_(F) ((bf16_t*)((F).ws + WS_V))
#define GT_(F) ((bf16_t*)((F).ws + WS_GATES))

    if (IN(0)) { PH_T0(); MKFRAME(F); p0_prologue(F); PH_SPIN(F, 0); }
    SEAM(0);

    if (IN(1)) {
        PH_T0();
        { MKFRAME(F);
          pg8::ABPlain g{XA_(F), (const bf16_t*)(F.ws + WS_WIN), DM}; pg8::StaticOrder S; S.init(T, 512, F.G, (int)blockIdx.x);
          epi::EpiInProj E{QB_(F), KB_(F), VB_(F), (bf16_t*)(F.ws + WS_UP), (bf16_t*)(F.ws + WS_QM), GT_(F), F.in[I_QN], F.in[I_KN], (const float*)(F.ws + WS_ROPE), (const float*)(F.ws + WS_ROPE) + SEQ * 32, F.in[I_BG], 0, 1.0f};
          GP_RESET(F); pg8::gemm_phase<epi::EpiInProj, pg8::StaticOrder, pg8::ABPlain, true, true>(F.tid, F.lds, g, S, E); GP_SPIN(F, 10); }
        WG_BAR();
        { MKFRAME(F);
          pg8::ABPlain8 g{(const bf16_t*)(F.ws + WS_XN8), (const bf16_t*)(F.ws + WS_WIN8), DM / 2}; pg8::StaticOrder S; S.init(T, 6656, F.G, (int)blockIdx.x);
          epi::EpiInProj E{QB_(F), KB_(F), VB_(F), (bf16_t*)(F.ws + WS_UP), (bf16_t*)(F.ws + WS_QM), GT_(F), F.in[I_QN], F.in[I_KN], (const float*)(F.ws + WS_ROPE), (const float*)(F.ws + WS_ROPE) + SEQ * 32, F.in[I_BG], 1, 1.0f / W8_SCALE};
          GP_RESET(F); pg8::gemm_phase<epi::EpiInProj, pg8::StaticOrder, pg8::ABPlain8, true, true>(F.tid, F.lds, g, S, E); GP_SPIN(F, 11); }
        WG_BAR();
        { MKFRAME(F);
          pg8::ABPlain g{(const bf16_t*)(F.ws + WS_MEMN), (const bf16_t*)(F.ws + WS_WKV), DM}; pg8::StaticOrder S; S.init(TM, DM, F.G, (int)blockIdx.x);
          epi::EpiMemKV E{(bf16_t*)(F.ws + WS_KM), (bf16_t*)(F.ws + WS_VM), F.in[I_MK], F.in[I_MQ]};
          if (F.G >= 64) pg8::gemm_phase<epi::EpiMemKV, pg8::StaticOrder, pg8::ABPlain, false, true>(F.tid, F.lds, g, S, E); }
        WG_BAR();
        { MKFRAME(Fp); PH_SPIN(Fp, 1); }
    }
    SEAM(1);

    if (IN(2)) {
        PH_T0();
#pragma unroll 1
        for (int rep_ = 0; rep_ < MK_P2_REP_A; ++rep_)
        { MKFRAME(F);
          float lam;
          { const float a = F.in[I_LQ1][F.lane] * F.in[I_LK1][F.lane], b = F.in[I_LQ2][F.lane] * F.in[I_LK2][F.lane];
            lam = __expf(wave_sum(a)) - __expf(wave_sum(b)) + LAMBDA_INIT; }
          const float* gsub = F.in[I_GSUB];
#pragma unroll 1
          for (int P = F.vcu; P < BATCH * 8 * 16; P += F.G) {
#pragma unroll 1
              for (int s = 0; s < 2; ++s) { const int bh = P >> 4, p = P & 15, qb = s ? 31 - p : p;
                  att::da_unit(F.tid, bh >> 3, bh & 7, qb, QB_(F), KB_(F), VB_(F), XA_(F), BR_LD, lam, gsub, F.lds, p); }
          }
#if DA_PROF
          if (F.wave == 0) { const unsigned n_ = (DA_PROF_SEL < 16) ? F.MISC[3300 + (DA_PROF_SEL & 15)] * DA_PROF_MUL : (unsigned)DA_PROF_SEL;
              const unsigned long long s_ = __builtin_amdgcn_s_memrealtime();
              while ((unsigned long long)__builtin_amdgcn_s_memrealtime() - s_ < (unsigned long long)n_) __builtin_amdgcn_s_sleep(8); }
          WG_BAR();
#endif
          }
#pragma unroll 1
        for (int rep_ = 0; rep_ < MK_P2_REP_B; ++rep_)
        { MKFRAME(F); p2_pool(F); }
#pragma unroll 1
        for (int rep_ = 0; rep_ < MK_P2_REP_C; ++rep_)
        { MKFRAME(F);
#pragma unroll 1
          for (int U = F.vcu; U < BATCH * 4 * 4; U += F.G)
              att::ca_unit(F.tid, U >> 4, (U >> 2) & 3, U & 3, (const bf16_t*)(F.ws + WS_QM), (const bf16_t*)(F.ws + WS_KM), (const bf16_t*)(F.ws + WS_VM), XA_(F) + BR_OM, BR_LD, F.lds); }
        { MKFRAME(Fp); PH_SPIN(Fp, 2); }
    }
    SEAM(2);

    if (IN(3)) {
        PH_T0();
        MKFRAME(F); pg8::ABPlain g{XA_(F), (const bf16_t*)(F.ws + WS_WCAT), BR_LD}; pg8::StaticOrder S; S.init(T, DM, F.G, (int)blockIdx.x);
        epi::EpiMerge3 E{GT_(F), VB_(F)};
        GP_RESET(F); pg8::gemm_phase<epi::EpiMerge3, pg8::StaticOrder, pg8::ABPlain, true, true>(F.tid, F.lds, g, S, E); GP_SPIN(F, 3);
        WG_BAR();
        { MKFRAME(Fp); PH_SPIN(Fp, 3); }
    }
    SEAM(3);

    if (IN(4)) {
        PH_T0();
        MKFRAME(F); pg8::ABPlain g{VB_(F), (const bf16_t*)(F.ws + WS_WOUT), DM}; pg8::StaticOrder S; S.init(T, DM, F.G, (int)blockIdx.x);
        epi::EpiOut E{F.in[I_X], XA_(F), F.ws + WS_HB8};
        GP_RESET(F); pg8::gemm_phase<epi::EpiOut, pg8::StaticOrder, pg8::ABPlain, true, true>(F.tid, F.lds, g, S, E); GP_SPIN(F, 4);
        WG_BAR();
        { MKFRAME(Fp); PH_SPIN(Fp, 4); }
    }
    SEAM(4);

    if (IN(5)) { PH_T0(); { MKFRAME(F); p5_router(F); } WG_BAR(); { MKFRAME(F); p5_expert_weights(F); } { MKFRAME(F); PH_SPIN(F, 5); } }
    SEAM(5);

    if (IN(6)) {
        PH_T0();
        MKFRAME(F);
        const unsigned* list = (const unsigned*)(F.ws + WS_LIST);
        moe_tables(F);
        pg8::ABMoeGU g{(const bf16_t*)(F.ws + WS_HB8), (const bf16_t*)(F.ws + WS_WGU8), list, DM / 2};
        pg8::MoeOrder S{(const volatile LAS int*)(F.MISC + MI_CNT), (const volatile LAS int*)(F.MISC + MI_CUM), (const volatile LAS int*)(F.MISC + MI_RB), 8, F.G, F.vcu, (int)F.MISC[MI_CUM + NE] * 8};
        epi::EpiGateUp E{(const float*)(F.ws + WS_RSLOT), F.in[I_BGATE], F.in[I_BUP], F.ws + WS_ACT8};
        GP_RESET(F); pg8::gemm_phase<epi::EpiGateUp, pg8::MoeOrder, pg8::ABMoeGU, true, true>(F.tid, F.lds, g, S, E); GP_SPIN(F, 6);
        WG_BAR();
        { MKFRAME(Fp); PH_SPIN(Fp, 6); }
    }
    SEAM(6);
    if (IN(7)) {
        PH_T0();
        MKFRAME(F);
        moe_tables(F);
        pg8::ABMoeDown g{(const bf16_t*)(F.ws + WS_ACT8), (const bf16_t*)(F.ws + WS_WD8), DM / 2};
        pg8::MoeOrder S{(const volatile LAS int*)(F.MISC + MI_CNT), (const volatile LAS int*)(F.MISC + MI_CUM), (const volatile LAS int*)(F.MISC + MI_RB), 4, F.G, F.vcu, (int)F.MISC[MI_CUM + NE] * 4};
        epi::EpiDown E{F.in[I_BDOWN], F.ws + WS_OSLOT};
        GP_RESET(F); pg8::gemm_phase<epi::EpiDown, pg8::MoeOrder, pg8::ABMoeDown, true, true>(F.tid, F.lds, g, S, E); GP_SPIN(F, 7);
        WG_BAR();
        { MKFRAME(Fp); PH_SPIN(Fp, 7); }
    }
    SEAM(7);
    if (IN(8)) { PH_T0(); MKFRAME(F); moe_tables(F); moe_combine(F); PH_SPIN(F, 8); }
#if GP_PROF
    if (GP_PROF_PHASE == 200) { const unsigned long long s_ = __builtin_amdgcn_s_memrealtime(); const unsigned long long n_ = s_ - kt0_;
        while ((unsigned long long)__builtin_amdgcn_s_memrealtime() - s_ < n_) __builtin_amdgcn_s_sleep(8); }
#endif
#undef IN
#undef SEAM
}

extern "C" void kernel_launch(void* const* d_in, const int* in_sizes, int n_in, void* d_out, int out_size, void* d_ws, size_t ws_size, hipStream_t stream) {
    static int grid = 0;
    if (grid == 0) {
        if (n_in != 31 || in_sizes[0] != T * DM || out_size != T * DM || ws_size < WS_END) { fprintf(stderr, "kernel_launch: unexpected shapes (n_in %d, in0 %d, out %d, ws %zu)\n", n_in, n_in > 0 ? in_sizes[0] : -1, out_size, ws_size); grid = -1; return; }
        int dev = 0, cus = 0, per_cu = 0;
        if (hipGetDevice(&dev) != hipSuccess || hipDeviceGetAttribute(&cus, hipDeviceAttributeMultiprocessorCount, dev) != hipSuccess) { grid = -1; return; }
        if (hipFuncSetAttribute((const void*)mk_fwd, hipFuncAttributeMaxDynamicSharedMemorySize, LDS_BYTES) != hipSuccess) { fprintf(stderr, "kernel_launch: hipFuncSetAttribute failed\n"); grid = -1; return; }
        if (hipOccupancyMaxActiveBlocksPerMultiprocessor(&per_cu, (const void*)mk_fwd, NWAVES * 64, LDS_BYTES) != hipSuccess || per_cu < 1) fprintf(stderr, "kernel_launch: occupancy query reports %d\n", per_cu);
        (void)hipGetLastError();
        grid = cus;
    }
    if (grid < 0) return;
    (void)hipMemsetAsync((char*)d_ws + WS_CTL, 0, CTL_ZERO_BYTES, stream);
    Args a{};
    for (int i = 0; i < 31; ++i) a.in[i] = (const float*)d_in[i];
    a.out = (float*)d_out; a.ws = (unsigned char*)d_ws;
#if MK_SPLIT
    for (int p = 0; p < N_PHASES; ++p) { const int reps = ((MK_REP_MASK >> p) & 1) ? 2 : 1;
        for (int r = 0; r < reps; ++r) { if (p == 5 && r > 0) (void)hipMemsetAsync((char*)d_ws + WS_CTL + CW_CNT * 4, 0, NE * 4, stream);
            a.ph_lo = p; a.ph_hi = p + 1; hipLaunchKernelGGL(mk_fwd, dim3(grid), dim3(NWAVES * 64), LDS_BYTES, stream, a); } }
#else
    a.ph_lo = 0; a.ph_hi = N_PHASES;
    hipLaunchKernelGGL(mk_fwd, dim3(grid), dim3(NWAVES * 64), LDS_BYTES, stream, a);
#endif
    const hipError_t le = hipPeekAtLastError();
    if (le != hipSuccess) fprintf(stderr, "kernel_launch: launch failed: %s\n", hipGetErrorName(le));
}
```
